# Optimizing an MI355X kernel written in HIP

```python
import math
import jax, jax.numpy as jnp
from jax import lax
import numpy as np

D_MODEL = 1024
BATCH = 8
SEQ = 2048
DEPTH = 1
DEC_BATCH = 128
DEC_SEQ = 4
PAST_LEN = 16384
PAGE_SIZE = 128

POOL_WINDOWS = (2, 4, 8, 16)
N_POOL_GROUPS = len(POOL_WINDOWS)
POOL_WIDTH = D_MODEL
POOL_GC = POOL_WIDTH // N_POOL_GROUPS
POOL_DG = D_MODEL // N_POOL_GROUPS
POOL_BUF = max(POOL_WINDOWS) - 1
GLA_HEADS = 4
GLA_DK = D_MODEL // 2 // GLA_HEADS
GLA_DV = D_MODEL // GLA_HEADS
QK_WIDTH = GLA_HEADS * GLA_DK
V_WIDTH = GLA_HEADS * GLA_DV
GK_RANK = 16
GATE_NORMALIZER = 16.0
GLA_CHUNK = 64
D_FF = 2816
PLE_DIM = 256
EPS = 1e-6
IN_SPLITS = (POOL_WIDTH, QK_WIDTH, QK_WIDTH, V_WIDTH, GK_RANK, V_WIDTH, D_MODEL, D_MODEL)
IN_WIDTH = sum(IN_SPLITS)

kernel_name = "hybrid_pool_gla_macaron_step"


def _rmsnorm(x, g):
    xf = x.astype(jnp.float32)
    y = xf * lax.rsqrt(jnp.mean(xf * xf, axis=-1, keepdims=True) + EPS)
    return (y * g.astype(jnp.float32)).astype(x.dtype)


def _swiglu(x, w_gate, w_up, w_down):
    return (jax.nn.silu(x @ w_gate) * (x @ w_up)) @ w_down


def _pool_mix(u, buf, pos0, pool_w, pool_scale):
    B, L, _ = u.shape
    ext = jnp.concatenate([buf.astype(jnp.float32), u.astype(jnp.float32)], axis=1)
    cs = jnp.concatenate([jnp.zeros((B, 1, POOL_WIDTH), jnp.float32), jnp.cumsum(ext, axis=1)], axis=1)
    end = cs[:, POOL_BUF + 1:]
    pos = pos0 + jnp.arange(L) + 1
    means = []
    for g, w in enumerate(POOL_WINDOWS):
        sl = slice(g * POOL_GC, (g + 1) * POOL_GC)
        start = cs[:, POOL_BUF + 1 - w: POOL_BUF + 1 - w + L, sl]
        cnt = jnp.minimum(w, pos).astype(jnp.float32)
        means.append((end[..., sl] - start) / cnt[None, :, None])
    pooled = jnp.concatenate(means, axis=-1) - u.astype(jnp.float32)
    pooled = pooled.reshape(B, L, N_POOL_GROUPS, POOL_GC).astype(u.dtype)
    out = jnp.einsum('blgc,gcd->blgd', pooled, pool_w).reshape(B, L, D_MODEL) * pool_scale
    new_buf = ext[:, -POOL_BUF:].astype(buf.dtype)
    return out, new_buf


def _gla(q, k, v, gk, S0):
    B, L, H, DK = q.shape
    DV = v.shape[-1]
    C = math.gcd(L, GLA_CHUNK)
    N = L // C

    def to_chunks(t):
        return t.astype(jnp.float32).reshape(B, N, C, H, t.shape[-1]).transpose(1, 0, 3, 2, 4)

    qc, kc, vc, gc = to_chunks(q), to_chunks(k), to_chunks(v), to_chunks(gk)
    mask = jnp.tril(jnp.ones((C, C), dtype=bool))

    def step(S, inp):
        qi, ki, vi, gi = inp
        b = jnp.cumsum(gi, axis=2)
        o_inter = jnp.einsum('bhic,bhcv->bhiv', qi * jnp.exp(b), S)
        diff = b[:, :, :, None, :] - b[:, :, None, :, :]
        decay = jnp.exp(jnp.where(mask[:, :, None], diff, -jnp.inf))
        A = jnp.einsum('bhic,bhjc,bhijc->bhij', qi, ki, decay)
        o = o_inter + jnp.einsum('bhij,bhjv->bhiv', A, vi)
        b_last = b[:, :, -1:, :]
        k_dec = ki * jnp.exp(b_last - b)
        S_new = S * jnp.exp(b_last[:, :, 0, :])[..., None] + jnp.einsum('bhjc,bhjv->bhcv', k_dec, vi)
        return S_new, o

    S, o = lax.scan(step, S0.astype(jnp.float32), (qc, kc, vc, gc))
    o = o.transpose(1, 0, 3, 2, 4).reshape(B, L, H, DV)
    return o, S


def _layer(x, p, buf, S0, pos0,
           ffn1_norm, ffn1_w_gate, ffn1_w_up, ffn1_w_down,
           mix_norm, w_in, w_gk_up, b_gk, gla_norm, pool_w, pool_scale, w_out,
           ffn2_norm, ffn2_w_gate, ffn2_w_up, ffn2_w_down,
           ple_norm, w_ple_gate, w_ple_proj):
    B, L, _ = x.shape
    h = x + 0.5 * _swiglu(_rmsnorm(x, ffn1_norm), ffn1_w_gate, ffn1_w_up, ffn1_w_down)
    xn = _rmsnorm(h, mix_norm)
    z = xn @ w_in
    offs = [int(o) for o in np.cumsum(IN_SPLITS)[:-1]]
    u, q, k, v, gk_lr, g, ga, gb = jnp.split(z, offs, axis=-1)
    a_out, new_buf = _pool_mix(u, buf, pos0, pool_w, pool_scale)
    gk = jax.nn.log_sigmoid((gk_lr @ w_gk_up + b_gk).astype(jnp.float32)) / GATE_NORMALIZER
    q = q.reshape(B, L, GLA_HEADS, GLA_DK) * (GLA_DK ** -0.5)
    k = k.reshape(B, L, GLA_HEADS, GLA_DK)
    v = v.reshape(B, L, GLA_HEADS, GLA_DV)
    gk = gk.reshape(B, L, GLA_HEADS, GLA_DK)
    o, S_new = _gla(q, k, v, gk, S0)
    o = _rmsnorm(o, gla_norm).reshape(B, L, V_WIDTH).astype(x.dtype)
    b_out = o * jax.nn.silu(g)
    mix = jax.nn.sigmoid(ga) * a_out + jax.nn.sigmoid(gb) * b_out
    h = h + mix @ w_out
    h = h + 0.5 * _swiglu(_rmsnorm(h, ffn2_norm), ffn2_w_gate, ffn2_w_up, ffn2_w_down)
    gate = jax.nn.sigmoid(_rmsnorm(h, ple_norm) @ w_ple_gate)
    h = h + gate * (p.astype(h.dtype) @ w_ple_proj)
    return h, new_buf, S_new.astype(S0.dtype)


def setup_inputs(seed: int = 0) -> dict:
    key = jax.random.key(seed)
    ks = jax.random.split(key, 32)
    f32 = jnp.float32

    def nrm(k, shape, scale=1.0):
        return jax.random.normal(k, shape, f32) * scale

    def gain(k, shape):
        return 1.0 + 0.05 * jax.random.normal(k, shape, f32)

    D, F = D_MODEL, D_FF
    return {
        "x_prompt": nrm(ks[0], (BATCH, SEQ, D)),
        "x_sample": nrm(ks[1], (DEC_BATCH, DEC_SEQ, D)),
        "p_prompt": nrm(ks[2], (DEPTH, BATCH, SEQ, PLE_DIM)),
        "p_sample": nrm(ks[3], (DEPTH, DEC_BATCH, DEC_SEQ, PLE_DIM)),
        "state_pool": nrm(ks[4], (DEPTH, DEC_BATCH, POOL_BUF, POOL_WIDTH)),
        "state_gla": nrm(ks[5], (DEPTH, DEC_BATCH, GLA_HEADS, GLA_DK, GLA_DV)),
        "ffn1_norm": gain(ks[6], (DEPTH, D)),
        "ffn1_w_gate": nrm(ks[7], (DEPTH, D, F), D ** -0.5),
        "ffn1_w_up": nrm(ks[8], (DEPTH, D, F), D ** -0.5),
        "ffn1_w_down": nrm(ks[9], (DEPTH, F, D), F ** -0.5),
        "mix_norm": gain(ks[10], (DEPTH, D)),
        "w_in": nrm(ks[11], (DEPTH, D, IN_WIDTH), D ** -0.5),
        "w_gk_up": nrm(ks[12], (DEPTH, GK_RANK, QK_WIDTH), GK_RANK ** -0.5),
        "b_gk": nrm(ks[13], (DEPTH, QK_WIDTH), 0.1),
        "gla_norm": gain(ks[14], (DEPTH, GLA_DV)),
        "pool_w": nrm(ks[15], (DEPTH, N_POOL_GROUPS, POOL_GC, POOL_DG), POOL_GC ** -0.5),
        "pool_scale": gain(ks[16], (DEPTH, D)),
        "w_out": nrm(ks[17], (DEPTH, D, D), D ** -0.5),
        "ffn2_norm": gain(ks[18], (DEPTH, D)),
        "ffn2_w_gate": nrm(ks[19], (DEPTH, D, F), D ** -0.5),
        "ffn2_w_up": nrm(ks[20], (DEPTH, D, F), D ** -0.5),
        "ffn2_w_down": nrm(ks[21], (DEPTH, F, D), F ** -0.5),
        "ple_norm": gain(ks[22], (DEPTH, D)),
        "w_ple_gate": nrm(ks[23], (DEPTH, D, D), D ** -0.5),
        "w_ple_proj": nrm(ks[24], (DEPTH, PLE_DIM, D), PLE_DIM ** -0.5),
        "final_norm": gain(ks[25], (D,)),
    }


def reference(x_prompt, x_sample, p_prompt, p_sample, state_pool, state_gla,
              ffn1_norm, ffn1_w_gate, ffn1_w_up, ffn1_w_down,
              mix_norm, w_in, w_gk_up, b_gk, gla_norm, pool_w, pool_scale, w_out,
              ffn2_norm, ffn2_w_gate, ffn2_w_up, ffn2_w_down,
              ple_norm, w_ple_gate, w_ple_proj, final_norm):
    B, L = x_prompt.shape[0], x_prompt.shape[1]
    hp, hs = x_prompt, x_sample
    pool_p, gla_p, pool_s, gla_s = [], [], [], []
    for i in range(DEPTH):
        lw = (ffn1_norm[i], ffn1_w_gate[i], ffn1_w_up[i], ffn1_w_down[i],
              mix_norm[i], w_in[i], w_gk_up[i], b_gk[i], gla_norm[i], pool_w[i], pool_scale[i], w_out[i],
              ffn2_norm[i], ffn2_w_gate[i], ffn2_w_up[i], ffn2_w_down[i],
              ple_norm[i], w_ple_gate[i], w_ple_proj[i])
        buf0 = jnp.zeros((B, POOL_BUF, POOL_WIDTH), state_pool.dtype)
        S0 = jnp.zeros((B, GLA_HEADS, GLA_DK, GLA_DV), state_gla.dtype)
        hp, bp, sp = _layer(hp, p_prompt[i], buf0, S0, 0, *lw)
        hs, bs, ss = _layer(hs, p_sample[i], state_pool[i], state_gla[i], PAST_LEN, *lw)
        pool_p.append(bp)
        gla_p.append(sp)
        pool_s.append(bs)
        gla_s.append(ss)
    y_prompt = _rmsnorm(hp, final_norm)
    y_sample = _rmsnorm(hs, final_norm)
    return (y_prompt, y_sample, jnp.stack(pool_p), jnp.stack(gla_p), jnp.stack(pool_s), jnp.stack(gla_s))
```

```cpp
#include <hip/hip_runtime.h>
#include <hip/hip_cooperative_groups.h>
#include <cstdio>
namespace cg = cooperative_groups;

#define LAS __attribute__((address_space(3)))
typedef unsigned short bf16_t;
typedef short bf16x8 __attribute__((ext_vector_type(8)));
typedef float f32x4 __attribute__((ext_vector_type(4)));
typedef float f32x2 __attribute__((ext_vector_type(2)));
typedef unsigned u32x4 __attribute__((ext_vector_type(4)));
typedef unsigned u32x2 __attribute__((ext_vector_type(2)));

constexpr int MP = 16384, MS = 512, M = MP + MS, D = 1024, FF = 2816, NIN = 6400, WIN_LD = 6160, ZLD = 3072;
constexpr float EPS = 1e-6f;
constexpr int NPH = 12;
constexpr size_t MiB = (size_t)1 << 20;
constexpr size_t OFF_WFFN = 1 * MiB;
constexpr size_t SZ_W1T = (size_t)5632 * 1024 * 2;
constexpr size_t OFF_AT = OFF_WFFN;
constexpr size_t OFF_DECL = OFF_AT + (size_t)1024 * 4096 * 2;
constexpr size_t OFF_GKLR = OFF_DECL + (size_t)1024 * 128 * 4;
constexpr size_t OFF_OSS = OFF_GKLR + (size_t)M * 16 * 4;
static_assert(OFF_OSS + (size_t)M * 64 * 4 <= OFF_WFFN + (size_t)3 * 1024 * 2816 * 2, "overlay fits");
constexpr size_t OFF_WIN = 18 * MiB;
constexpr size_t OFF_WPT = OFF_WIN + (size_t)NIN * 1024 * 2;
constexpr size_t OFF_WOUT = OFF_WPT + (size_t)1024 * 256 * 2;
constexpr size_t OFF_WPG = OFF_WOUT + (size_t)1024 * 1024 * 2;
constexpr size_t OFF_WPP = OFF_WPG + (size_t)1024 * 1024 * 2;
static_assert(OFF_WPP + (size_t)1024 * 256 * 2 <= 36 * MiB, "w rest");
constexpr size_t OFF_HB = 36 * MiB;
constexpr size_t OFF_BIG = 69 * MiB;
constexpr size_t OFF_SGA = 168 * MiB;
constexpr size_t OFF_P = 201 * MiB;
constexpr size_t OFF_PB = 234 * MiB;
constexpr size_t OFF_SSA = 243 * MiB;
constexpr size_t OFF_SSB = 245 * MiB;
constexpr size_t WS_END = 247 * MiB;
constexpr size_t OUT_NPP = (size_t)M * 1024;
constexpr size_t OUT_NGP = OUT_NPP + (size_t)8 * 15 * 1024;
constexpr size_t OUT_NPS = OUT_NGP + (size_t)8 * 4 * 128 * 256;
constexpr size_t OUT_NGS = OUT_NPS + (size_t)128 * 15 * 1024;
constexpr int LDS_BYTES = 147456;

typedef __bf16 bf16v2_t __attribute__((ext_vector_type(2)));
__device__ __forceinline__ unsigned cvt_pk_bf16(float lo, float hi) { bf16v2_t v; v[0] = (__bf16)lo; v[1] = (__bf16)hi; return __builtin_bit_cast(unsigned, v); }
__device__ __forceinline__ float bf_lo(unsigned w) { return __uint_as_float(w << 16); }
__device__ __forceinline__ float bf_hi(unsigned w) { return __uint_as_float(w & 0xffff0000u); }
__device__ __forceinline__ float bf1(bf16_t b) { return __uint_as_float(((unsigned)b) << 16); }
__device__ __forceinline__ bf16_t f2bf(float f) { return (bf16_t)(cvt_pk_bf16(f, 0.f) & 0xffffu); }
__device__ __forceinline__ u32x2 pack4(f32x4 v) { u32x2 w; w.x = cvt_pk_bf16(v[0], v[1]); w.y = cvt_pk_bf16(v[2], v[3]); return w; }
__device__ __forceinline__ u32x4 pack8(f32x4 a, f32x4 b) { u32x4 w; w.x = cvt_pk_bf16(a[0], a[1]); w.y = cvt_pk_bf16(a[2], a[3]); w.z = cvt_pk_bf16(b[0], b[1]); w.w = cvt_pk_bf16(b[2], b[3]); return w; }
__device__ __forceinline__ f32x4 unpack_lo(u32x4 w) { return (f32x4){bf_lo(w.x), bf_hi(w.x), bf_lo(w.y), bf_hi(w.y)}; }
__device__ __forceinline__ f32x4 unpack_hi(u32x4 w) { return (f32x4){bf_lo(w.z), bf_hi(w.z), bf_lo(w.w), bf_hi(w.w)}; }
__device__ __forceinline__ f32x4 unpack4(u32x2 w) { return (f32x4){bf_lo(w.x), bf_hi(w.x), bf_lo(w.y), bf_hi(w.y)}; }
__device__ __forceinline__ float sigmoidf_(float x) { return __builtin_amdgcn_rcpf(1.0f + __builtin_amdgcn_exp2f(-1.4426950409f * x)); }
__device__ __forceinline__ f32x4 sigmoid4(f32x4 x) { return (f32x4){sigmoidf_(x[0]), sigmoidf_(x[1]), sigmoidf_(x[2]), sigmoidf_(x[3])}; }
__device__ __forceinline__ float sum16(const float* p) { const f32x4* q = (const f32x4*)p; const f32x4 a = q[0], b = q[1], c = q[2], d = q[3];
    return ((a[0] + a[1]) + (a[2] + a[3])) + ((b[0] + b[1]) + (b[2] + b[3])) + ((c[0] + c[1]) + (c[2] + c[3])) + ((d[0] + d[1]) + (d[2] + d[3])); }
__device__ __forceinline__ float rowscale(const float* ss, int row, float invn) { return 1.0f / sqrtf(sum16(ss + (size_t)row * 16) * invn + EPS); }
__device__ __forceinline__ float wave_sum(float v) {
#pragma unroll
    for (int o = 1; o < 64; o <<= 1) v += __shfl_xor(v, o);
    return v; }

namespace pg8 {
constexpr int BM = 256, BK = 64, HALF = 128, HTB = HALF * BK * 2, NXCD = 8, WGM = 4;
__device__ __forceinline__ int lds_byte(int r, int c) { const int st = (r >> 4) * 2 + (c >> 5), rr = r & 15, cc = c & 31, ob = rr * 64 + cc * 2; return st * 1024 + (ob ^ (((ob >> 9) & 1) << 5)); }
__device__ __forceinline__ void stage_rc(int b, int& R, int& C) { const int st = b / 1024, sb = b % 1024, swz = sb ^ (((sb >> 9) & 1) << 5); R = (st >> 1) * 16 + swz / 64; C = (st & 1) * 32 + (swz % 64) / 2; }
struct Unit { int pm, pn; };
struct Gemm { const bf16_t* A; const bf16_t* Bt; int K, lda, ldb, a_pn_off; };
struct StaticOrder {
    int nM, nN, nwg, G, c;
    __device__ void init(int M_, int N_, int G_, int c_) { nM = M_ / BM; nN = N_ / BM; nwg = nM * nN; G = G_; c = c_; }
    __device__ bool next(int i, Unit& u) const {
        const long L = (long)i * G + c; if (L >= nwg) return false;
        int wgid = (int)L; { const int q = nwg / NXCD, r = nwg % NXCD, xcd = wgid % NXCD, off = wgid / NXCD; wgid = (xcd < r ? xcd * (q + 1) : r * (q + 1) + (xcd - r) * q) + off; }
        const int nig = WGM * nN, gid = wgid / nig, fm = gid * WGM, gsz = (nM - fm) < WGM ? (nM - fm) : WGM;
        u.pm = fm + ((wgid % nig) % gsz); u.pn = (wgid % nig) / gsz; return true;
    }
};
template <class Epi>
__device__ __forceinline__ void gemm_phase(LAS unsigned char* lds, const Gemm g, const StaticOrder& S, const Epi& E) {
    const int tid = threadIdx.x, wid = __builtin_amdgcn_readfirstlane(tid >> 6), lane = tid & 63, wr = wid >> 2, wc = wid & 3, fr = lane & 15, fq = lane >> 4;
    int K_ = g.K; asm volatile("" : "+s"(K_));
    const int K = K_, nt = K / BK;
    unsigned voffA[2], voffB[2];
#pragma unroll
    for (int i = 0; i < 2; ++i) { int R, C; stage_rc(tid * 16 + i * 8192, R, C); voffA[i] = (unsigned)(R * g.lda + C) * 2u; voffB[i] = (unsigned)(R * g.ldb + C) * 2u; }
    const size_t kstep = (size_t)(BK * 2);
    const size_t hsA = (size_t)HALF * g.lda * 2, hsB = (size_t)HALF * g.ldb * 2, tsA = 2 * hsA, tsB = 2 * hsB;
    const unsigned ldsw = (unsigned)wid * 1024u;
    const int aoff = lds_byte(wr * 64 + fr, fq * 8), boff = lds_byte(wc * 32 + fr, fq * 8);
#define PG8_SA(b, h) (((b) * 2 + (h)) * HTB)
#define PG8_SB(b, h) ((4 + (b) * 2 + (h)) * HTB)
#define PG8_STAGE(bufoff, gbase, voff) do { _Pragma("unroll") for (int _i = 0; _i < 2; ++_i) \
        __builtin_amdgcn_global_load_lds((const unsigned*)((const char*)(gbase) + (voff)[_i]), (LAS unsigned*)(lds + (bufoff) + ldsw + _i * 8192), 16, 0, 0); } while (0)
#define PG8_LDA(dst, b, h) do { _Pragma("unroll") for (int m = 0; m < 4; ++m) _Pragma("unroll") for (int k = 0; k < 2; ++k) dst[m][k] = *(const LAS bf16x8*)(lds + PG8_SA(b, h) + aoff + m * 2048 + k * 1024); } while (0)
#define PG8_LDB(dst, b, h) do { _Pragma("unroll") for (int n = 0; n < 2; ++n) _Pragma("unroll") for (int k = 0; k < 2; ++k) dst[n][k] = *(const LAS bf16x8*)(lds + PG8_SB(b, h) + boff + n * 2048 + k * 1024); } while (0)
#define PG8_MMA(ai, bj, At, Bt) do { __builtin_amdgcn_s_setprio(1); _Pragma("unroll") for (int m = 0; m < 4; ++m) _Pragma("unroll") for (int n = 0; n < 2; ++n) _Pragma("unroll") for (int k = 0; k < 2; ++k) \
        acc[ai][bj][m][n] = __builtin_amdgcn_mfma_f32_16x16x32_bf16(Bt[n][k], At[m][k], acc[ai][bj][m][n], 0, 0, 0); __builtin_amdgcn_s_setprio(0); } while (0)
#define PG8_WAIT_V(n) asm volatile("s_waitcnt vmcnt(" #n ")" ::: "memory")
#define PG8_WAIT_L(n) asm volatile("s_waitcnt lgkmcnt(" #n ")" ::: "memory")
#define PG8_BAR __builtin_amdgcn_s_barrier()
#define PG8_SCHED __builtin_amdgcn_sched_barrier(0)
    Unit cur, nxt; int ui = 0;
    if (!S.next(0, cur)) return;
    f32x4 acc[2][2][4][2];
#pragma unroll
    for (int a = 0; a < 2; ++a)
#pragma unroll
        for (int b = 0; b < 2; ++b)
#pragma unroll
            for (int m = 0; m < 4; ++m)
#pragma unroll
                for (int n = 0; n < 2; ++n) acc[a][b][m][n] = (f32x4){0.f, 0.f, 0.f, 0.f};
    bf16x8 At[4][2], B0[2][2], B1[2][2];
    const char* cA = (const char*)g.A + (size_t)cur.pm * tsA + (size_t)cur.pn * g.a_pn_off; const char* cB = (const char*)g.Bt + (size_t)cur.pn * tsB;
    PG8_STAGE(PG8_SB(0, 0), cB, voffB); PG8_STAGE(PG8_SA(0, 0), cA, voffA); PG8_STAGE(PG8_SB(0, 1), cB + hsB, voffB); PG8_STAGE(PG8_SA(0, 1), cA + hsA, voffA);
    if (wr == 1) PG8_BAR;
    PG8_WAIT_V(4); PG8_BAR;
    PG8_STAGE(PG8_SB(1, 0), cB + kstep, voffB); PG8_STAGE(PG8_SA(1, 0), cA + kstep, voffA); PG8_STAGE(PG8_SB(1, 1), cB + hsB + kstep, voffB);
    PG8_WAIT_V(6); PG8_BAR;
    for (;;) {
        const bool has_next = S.next(ui + 1, nxt);
        const char* nA = has_next ? (const char*)g.A + (size_t)nxt.pm * tsA + (size_t)nxt.pn * g.a_pn_off : cA; const char* nB = has_next ? (const char*)g.Bt + (size_t)nxt.pn * tsB : cB;
#pragma unroll 1
        for (int t = 0; t < nt; t += 2) {
            const bool last = (t == nt - 2);
            const char* a1 = cA + (size_t)(t + 1) * kstep;
            const char* a2 = last ? nA : cA + (size_t)(t + 2) * kstep; const char* b2 = last ? nB : cB + (size_t)(t + 2) * kstep;
            const char* a3 = a2 + kstep; const char* b3 = b2 + kstep;
            PG8_LDB(B0, 0, 0); PG8_SCHED; PG8_LDA(At, 0, 0); PG8_STAGE(PG8_SA(1, 1), a1 + hsA, voffA);
            PG8_WAIT_L(8); PG8_BAR; PG8_WAIT_L(0); PG8_MMA(0, 0, At, B0); PG8_BAR; PG8_SCHED;
            PG8_LDB(B1, 0, 1); PG8_STAGE(PG8_SB(0, 0), b2, voffB);
            PG8_BAR; PG8_WAIT_L(0); PG8_MMA(0, 1, At, B1); PG8_BAR;
            PG8_LDA(At, 0, 1); PG8_STAGE(PG8_SA(0, 0), a2, voffA);
            PG8_BAR; PG8_WAIT_L(0); PG8_MMA(1, 0, At, B0); PG8_BAR; PG8_SCHED;
            PG8_STAGE(PG8_SB(0, 1), b2 + hsB, voffB);
            PG8_WAIT_V(6); PG8_BAR; PG8_MMA(1, 1, At, B1); PG8_BAR;
            PG8_LDB(B0, 1, 0); PG8_SCHED; PG8_LDA(At, 1, 0); PG8_STAGE(PG8_SA(0, 1), a2 + hsA, voffA);
            PG8_WAIT_L(8); PG8_BAR; PG8_WAIT_L(0); PG8_MMA(0, 0, At, B0); PG8_BAR; PG8_SCHED;
            PG8_LDB(B1, 1, 1); PG8_STAGE(PG8_SB(1, 0), b3, voffB);
            PG8_BAR; PG8_WAIT_L(0); PG8_MMA(0, 1, At, B1); PG8_BAR;
            PG8_LDA(At, 1, 1); PG8_STAGE(PG8_SA(1, 0), a3, voffA);
            PG8_BAR; PG8_WAIT_L(0); PG8_MMA(1, 0, At, B0); PG8_BAR; PG8_SCHED;
            PG8_STAGE(PG8_SB(1, 1), b3 + hsB, voffB);
            PG8_WAIT_V(6); PG8_BAR; PG8_MMA(1, 1, At, B1); PG8_BAR;
        }
        E(acc, cur, ui, wr, wc, fr, fq);
        if (!has_next) break;
#pragma unroll
        for (int a = 0; a < 2; ++a)
#pragma unroll
            for (int b = 0; b < 2; ++b)
#pragma unroll
                for (int m = 0; m < 4; ++m)
#pragma unroll
                    for (int n = 0; n < 2; ++n) acc[a][b][m][n] = (f32x4){0.f, 0.f, 0.f, 0.f};
        cur = nxt; cA = nA; cB = nB; ++ui;
    }
    PG8_WAIT_V(0);
    if (wr == 0) PG8_BAR;
    PG8_BAR;
#undef PG8_SA
#undef PG8_SB
#undef PG8_STAGE
#undef PG8_LDA
#undef PG8_LDB
#undef PG8_MMA
#undef PG8_WAIT_V
#undef PG8_WAIT_L
#undef PG8_BAR
#undef PG8_SCHED
}
}
using pg8::Unit;
typedef const f32x4 (&AccRef)[2][2][4][2];
constexpr int RS_OFF = 131072;
__device__ __forceinline__ void fill_rs(LAS unsigned char* lds, const pg8::StaticOrder& S, const float* ss) {
    LAS float* tab = (LAS float*)(lds + RS_OFF); Unit u; const int wave = threadIdx.x >> 6, lane = threadIdx.x & 63;
    if (S.next(wave, u)) { float v[4];
#pragma unroll
        for (int k = 0; k < 4; ++k) v[k] = sum16(ss + (size_t)(u.pm * 256 + lane + 64 * k) * 16);
#pragma unroll
        for (int k = 0; k < 4; ++k) tab[wave * 256 + lane + 64 * k] = 1.0f / sqrtf(v[k] * (1.0f / 1024.0f) + EPS); }
    __syncthreads();
}
__device__ __forceinline__ void fill_rso(LAS unsigned char* lds, const pg8::StaticOrder& S, const float* oss) {
    LAS float* tab = (LAS float*)(lds + RS_OFF); Unit u; const int wave = threadIdx.x >> 6, lane = threadIdx.x & 63;
    if (S.next(wave, u)) { float v[4];
#pragma unroll
        for (int k = 0; k < 4; ++k) v[k] = sum16(oss + (size_t)(u.pm * 256 + lane + 64 * k) * 64 + u.pn * 16);
#pragma unroll
        for (int k = 0; k < 4; ++k) tab[wave * 256 + lane + 64 * k] = 1.0f / sqrtf(v[k] * (1.0f / 256.0f) + EPS); }
    __syncthreads();
}
struct EpiSwiglu { bf16_t* act; const LAS float* rs_tab;
    __device__ __forceinline__ void operator()(AccRef acc, const Unit& u, int ui, int wr, int wc, int fr, int fq) const {
        const int rl0 = wr * 64 + fr; const LAS float* tab = rs_tab + ui * 256 + rl0;
        bf16_t* base = act + (size_t)(u.pm * 256 + rl0) * FF + u.pn * 128 + wc * 32 + fq * 8;
#pragma unroll
        for (int ai = 0; ai < 2; ++ai)
#pragma unroll
            for (int m = 0; m < 4; ++m) { const int rl = ai * 128 + m * 16; const float rs = tab[rl]; f32x4 o[2];
#pragma unroll
                for (int bj = 0; bj < 2; ++bj) { const f32x4 gt = acc[ai][bj][m][0] * rs, up = acc[ai][bj][m][1] * rs; o[bj] = gt * sigmoid4(gt) * up; }
                *(u32x4*)(base + (size_t)rl * FF) = pack8(o[0], o[1]); }
    } };
struct EpiResid { bf16_t* hb; float* ssw; float scale;
    __device__ __forceinline__ void operator()(AccRef acc, const Unit& u, int ui, int wr, int wc, int fr, int fq) const {
        const int row0 = u.pm * 256 + wr * 64 + fr, col0 = u.pn * 256 + wc * 32 + fq * 8;
        bf16_t* hbase = hb + (size_t)row0 * 1024 + col0; float* sbase = ssw + (size_t)row0 * 16 + u.pn * 4 + wc;
        u32x4 r[8][2];
#pragma unroll
        for (int g = 0; g < 8; ++g) { const int rl = (g >> 2) * 128 + (g & 3) * 16;
#pragma unroll
            for (int bj = 0; bj < 2; ++bj) r[g][bj] = *(const u32x4*)(hbase + (size_t)rl * 1024 + bj * 128); }
#pragma unroll
        for (int g = 0; g < 8; ++g) { const int ai = g >> 2, m = g & 3, rl = ai * 128 + m * 16; float sq = 0.f;
#pragma unroll
            for (int bj = 0; bj < 2; ++bj) { const f32x4 v0 = unpack_lo(r[g][bj]) + acc[ai][bj][m][0] * scale, v1 = unpack_hi(r[g][bj]) + acc[ai][bj][m][1] * scale;
                *(u32x4*)(hbase + (size_t)rl * 1024 + bj * 128) = pack8(v0, v1);
                sq += ((v0[0] * v0[0] + v0[1] * v0[1]) + (v0[2] * v0[2] + v0[3] * v0[3])) + ((v1[0] * v1[0] + v1[1] * v1[1]) + (v1[2] * v1[2] + v1[3] * v1[3])); }
            sq += __shfl_xor(sq, 16); sq += __shfl_xor(sq, 32);
            if (fq == 0) sbase[(size_t)rl * 16] = sq; }
    } };
struct EpiZ { bf16_t* zA; bf16_t* sga; bf16_t* P; float* gklr; const LAS float* rs_tab; const float* gnorm;
    __device__ __forceinline__ void operator()(AccRef acc, const Unit& u, int ui, int wr, int wc, int fr, int fq) const {
        const int rl0 = wr * 64 + fr, row0 = u.pm * 256 + rl0; const int pn = u.pn; const LAS float* tab = rs_tab + ui * 256 + rl0;
        if (pn < 12) { bf16_t* base = zA + (size_t)row0 * ZLD + pn * 256 + wc * 32 + fq * 8;
#pragma unroll
            for (int ai = 0; ai < 2; ++ai)
#pragma unroll
                for (int m = 0; m < 4; ++m) { const int rl = ai * 128 + m * 16; const float rs = tab[rl];
#pragma unroll
                    for (int bj = 0; bj < 2; ++bj) *(u32x4*)(base + (size_t)rl * ZLD + bj * 128) = pack8(acc[ai][bj][m][0] * rs, acc[ai][bj][m][1] * rs); }
        } else if (pn < 16) { bf16_t* base = sga + (size_t)row0 * 1024 + (pn - 12) * 256 + wc * 32 + fq * 8;
#pragma unroll
            for (int ai = 0; ai < 2; ++ai)
#pragma unroll
                for (int m = 0; m < 4; ++m) { const int rl = ai * 128 + m * 16; const float rs = tab[rl];
#pragma unroll
                    for (int bj = 0; bj < 2; ++bj) *(u32x4*)(base + (size_t)rl * 1024 + bj * 128) = pack8(sigmoid4(acc[ai][bj][m][0] * rs), sigmoid4(acc[ai][bj][m][1] * rs)); }
        } else if (pn < 24) { const int c0 = (pn - 16) * 128 + wc * 32 + fq * 8; bf16_t* base = P + (size_t)row0 * 1024 + c0;
            const f32x4 gn0 = *(const f32x4*)(gnorm + (c0 & 255)), gn1 = *(const f32x4*)(gnorm + ((c0 + 4) & 255));
#pragma unroll
            for (int ai = 0; ai < 2; ++ai)
#pragma unroll
                for (int m = 0; m < 4; ++m) { const int rl = ai * 128 + m * 16; const float rs = tab[rl]; f32x4 o[2];
#pragma unroll
                    for (int bj = 0; bj < 2; ++bj) { const f32x4 gv = acc[ai][bj][m][0] * rs, gb = acc[ai][bj][m][1] * rs; o[bj] = sigmoid4(gb) * gv * sigmoid4(gv) * (bj ? gn1 : gn0); }
                    *(u32x4*)(base + (size_t)rl * 1024) = pack8(o[0], o[1]); }
        } else if (wc == 0 && fq < 2) {
#pragma unroll
            for (int ai = 0; ai < 2; ++ai)
#pragma unroll
                for (int m = 0; m < 4; ++m) { const int rl = ai * 128 + m * 16; const float rs = tab[rl];
                    *(f32x4*)(gklr + (size_t)(row0 + rl) * 16 + fq * 8) = acc[ai][0][m][0] * rs; *(f32x4*)(gklr + (size_t)(row0 + rl) * 16 + fq * 8 + 4) = acc[ai][0][m][1] * rs; }
        }
    } };
struct EpiMix { bf16_t* sga; const bf16_t* P; const bf16_t* o; const LAS float* rso_tab;
    __device__ __forceinline__ void operator()(AccRef acc, const Unit& u, int ui, int wr, int wc, int fr, int fq) const {
        const int rl0 = wr * 64 + fr, row0 = u.pm * 256 + rl0; const int colb = u.pn * 256 + wc * 32 + fq * 8; const LAS float* tab = rso_tab + ui * 256 + rl0;
        bf16_t* sb = sga + (size_t)row0 * 1024 + colb; const bf16_t* pb_ = P + (size_t)row0 * 1024 + colb; const bf16_t* ob = o + (size_t)row0 * ZLD + colb;
        u32x4 ro[3][2], rsg[3][2], rp[3][2];
#define MIX_LD(slot, g_) do { const int rl_ = ((g_) >> 2) * 128 + ((g_) & 3) * 16; _Pragma("unroll") for (int bj = 0; bj < 2; ++bj) { \
            ro[slot][bj] = *(const u32x4*)(ob + (size_t)rl_ * ZLD + bj * 128); rsg[slot][bj] = *(const u32x4*)(sb + (size_t)rl_ * 1024 + bj * 128); rp[slot][bj] = *(const u32x4*)(pb_ + (size_t)rl_ * 1024 + bj * 128); } } while (0)
        MIX_LD(0, 0); MIX_LD(1, 1); MIX_LD(2, 2);
#pragma unroll
        for (int g = 0; g < 8; ++g) { const int ai = g >> 2, m = g & 3, rl = ai * 128 + m * 16; const float rso = tab[rl]; u32x4 res[2];
#pragma unroll
            for (int bj = 0; bj < 2; ++bj) res[bj] = pack8(unpack_lo(rsg[g % 3][bj]) * acc[ai][bj][m][0] + unpack_lo(rp[g % 3][bj]) * (unpack_lo(ro[g % 3][bj]) * rso),
                                                           unpack_hi(rsg[g % 3][bj]) * acc[ai][bj][m][1] + unpack_hi(rp[g % 3][bj]) * (unpack_hi(ro[g % 3][bj]) * rso));
            if (g + 3 < 8) MIX_LD(g % 3, g + 3);
#pragma unroll
            for (int bj = 0; bj < 2; ++bj) *(u32x4*)(sb + (size_t)rl * 1024 + bj * 128) = res[bj];
        }
#undef MIX_LD
    } };
struct EpiBf16 { bf16_t* out;
    __device__ __forceinline__ void operator()(AccRef acc, const Unit& u, int ui, int wr, int wc, int fr, int fq) const {
        bf16_t* base = out + (size_t)(u.pm * 256 + wr * 64 + fr) * 1024 + u.pn * 256 + wc * 32 + fq * 8;
#pragma unroll
        for (int ai = 0; ai < 2; ++ai)
#pragma unroll
            for (int m = 0; m < 4; ++m)
#pragma unroll
                for (int bj = 0; bj < 2; ++bj) *(u32x4*)(base + (size_t)(ai * 128 + m * 16) * 1024 + bj * 128) = pack8(acc[ai][bj][m][0], acc[ai][bj][m][1]);
    } };
struct EpiPle { float* h; const bf16_t* hb; const bf16_t* pp; const LAS float* rs_tab; float* ssw;
    __device__ __forceinline__ void operator()(AccRef acc, const Unit& u, int ui, int wr, int wc, int fr, int fq) const {
        const int rl0 = wr * 64 + fr, row0 = u.pm * 256 + rl0, col0 = u.pn * 256 + wc * 32 + fq * 8; const LAS float* tab = rs_tab + ui * 256 + rl0;
        float* obase = h + (size_t)row0 * 1024 + col0; const bf16_t* hbase = hb + (size_t)row0 * 1024 + col0; const bf16_t* pbase = pp + (size_t)row0 * 1024 + col0; float* sbase = ssw + (size_t)row0 * 16 + u.pn * 4 + wc;
        u32x4 rh[4][2], rp[4][2];
#define PLE_LD(slot, g_) do { const int rl_ = ((g_) >> 2) * 128 + ((g_) & 3) * 16; _Pragma("unroll") for (int bj = 0; bj < 2; ++bj) { \
            rh[slot][bj] = *(const u32x4*)(hbase + (size_t)rl_ * 1024 + bj * 128); rp[slot][bj] = *(const u32x4*)(pbase + (size_t)rl_ * 1024 + bj * 128); } } while (0)
        PLE_LD(0, 0); PLE_LD(1, 1); PLE_LD(2, 2); PLE_LD(3, 3);
#pragma unroll
        for (int g = 0; g < 8; ++g) { const int ai = g >> 2, m = g & 3, rl = ai * 128 + m * 16; const float rs = tab[rl]; float sq = 0.f; f32x4 res[2][2];
#pragma unroll
            for (int bj = 0; bj < 2; ++bj) { const f32x4 v0 = unpack_lo(rh[g & 3][bj]) + sigmoid4(acc[ai][bj][m][0] * rs) * unpack_lo(rp[g & 3][bj]), v1 = unpack_hi(rh[g & 3][bj]) + sigmoid4(acc[ai][bj][m][1] * rs) * unpack_hi(rp[g & 3][bj]);
                res[bj][0] = v0; res[bj][1] = v1; sq += ((v0[0] * v0[0] + v0[1] * v0[1]) + (v0[2] * v0[2] + v0[3] * v0[3])) + ((v1[0] * v1[0] + v1[1] * v1[1]) + (v1[2] * v1[2] + v1[3] * v1[3])); }
            if (g + 4 < 8) PLE_LD(g & 3, g + 4);
#pragma unroll
            for (int bj = 0; bj < 2; ++bj) { *(f32x4*)(obase + (size_t)rl * 1024 + bj * 128) = res[bj][0]; *(f32x4*)(obase + (size_t)rl * 1024 + bj * 128 + 4) = res[bj][1]; }
            sq += __shfl_xor(sq, 16); sq += __shfl_xor(sq, 32);
            if (fq == 0) sbase[(size_t)rl * 16] = sq; }
#undef PLE_LD
    } };

struct Params { const float* in[26]; float* out; unsigned char* ws; int ph_lo, ph_hi; };

template <int MODE>
__device__ __forceinline__ void tr_item(const float* src0, const float* src1, int ldsrc, int K, bf16_t* dst, const float* gain, LAS float* scr, int item, int nblk, int lane, const float* cs = nullptr) {
    const int kb = item / nblk, nb = item % nblk, k0 = 64 * kb, n0 = 32 * nb;
    const int r8 = lane >> 3, c4 = (lane & 7) * 4; const float* sp; f32x4 sc = (f32x4){1.f, 1.f, 1.f, 1.f};
    const int lc = 8 * ((c4 >> 2) & 3) + 4 * (c4 >> 4);
    const int gq = (n0 & 255) >> 5, fi = (n0 >> 8) * 128 + (gq & 3) * 32 + ((c4 >> 2) & 3) * 8 + (gq >> 2) * 4;
    if (MODE == 0) { sp = src0 + n0 + lc; if (cs) sc = *(const f32x4*)(cs + n0 + lc); }
    else if (MODE == 1) { sp = ((c4 >> 4) ? src1 : src0) + fi; }
    else { const int n = n0 + lc;
           if (n0 < 3072) { sp = src0 + n; if (n0 >= 1024 && n0 < 1536) sc = sc * 0.08838834764831845f; }
           else if (n0 < 4096) sp = src0 + 4112 + (n - 3072);
           else if (n0 < 6144) sp = src0 + ((c4 >> 4) ? 5136 : 3088) + (fi - 2048);
           else if (n0 == 6144 && lc < 16) sp = src0 + 3072 + lc;
           else sp = nullptr; }
    f32x4 v[8];
#pragma unroll
    for (int i = 0; i < 8; ++i) { const int kk = 8 * i + r8; v[i] = sp ? *(const f32x4*)(sp + (size_t)(k0 + kk) * ldsrc) : (f32x4){0.f, 0.f, 0.f, 0.f}; }
#pragma unroll
    for (int i = 0; i < 8; ++i) { const int kk = 8 * i + r8; f32x4 t = v[i] * sc; if (gain) t = t * gain[k0 + kk];
        scr[kk * 33 + c4] = t[0]; scr[kk * 33 + c4 + 1] = t[1]; scr[kk * 33 + c4 + 2] = t[2]; scr[kk * 33 + c4 + 3] = t[3]; }
    asm volatile("s_waitcnt lgkmcnt(0)" ::: "memory");
    const int c = lane & 7;
#pragma unroll
    for (int j = 0; j < 4; ++j) { const int nn = (lane >> 3) + 8 * j; const LAS float* s_ = scr + (8 * c) * 33 + nn;
        u32x4 o; o.x = cvt_pk_bf16(s_[0 * 33], s_[1 * 33]); o.y = cvt_pk_bf16(s_[2 * 33], s_[3 * 33]); o.z = cvt_pk_bf16(s_[4 * 33], s_[5 * 33]); o.w = cvt_pk_bf16(s_[6 * 33], s_[7 * 33]);
        *(u32x4*)(dst + (size_t)(n0 + nn) * K + k0 + 8 * c) = o; }
    asm volatile("s_waitcnt lgkmcnt(0)" ::: "memory");
}
__device__ __forceinline__ void conv_ffn(const Params& p, int base, bf16_t* w1t, LAS float* scr, int gw, int NGW, int lane, int part = 0) {
    bf16_t* w2t = w1t + SZ_W1T / 2;
    constexpr int I1 = 16 * 176, I2 = 44 * 32;
    const int lo_ = (part == 2) ? I1 : 0, hi_ = (part == 1) ? I1 : I1 + I2;
    for (int it = lo_ + gw; it < hi_; it += NGW) {
        if (it < I1) tr_item<1>(p.in[base + 1], p.in[base + 2], FF, 1024, w1t, p.in[base], scr, it, 176, lane);
        else tr_item<0>(p.in[base + 3], nullptr, 1024, FF, w2t, nullptr, scr, it - I1, 32, lane);
    }
}
constexpr size_t Y_FFN2_OFF = (size_t)33 * MiB;
__device__ __forceinline__ void conv_rest(const Params& p, LAS unsigned char* lds, int gw, int NGW) {
    const int tid = threadIdx.x, lane = tid & 63, wave = tid >> 6; LAS float* scr = (LAS float*)(lds + wave * 16384); unsigned char* ws = p.ws;
    constexpr int I_IN = 16 * 200, I_POOL = 4 * 4 * 8, I_OUT = 16 * 32, I_PG = 16 * 32, I_PP = 4 * 32;
    for (int it = gw; it < I_IN + I_POOL + I_OUT + I_PG + I_PP; it += NGW) {
        int r = it;
        if (r < I_IN) { tr_item<2>(p.in[11], nullptr, WIN_LD, 1024, (bf16_t*)(ws + OFF_WIN), p.in[10], scr, r, 200, lane); continue; } r -= I_IN;
        if (r < I_POOL) { const int g = r >> 5; tr_item<0>(p.in[15] + (size_t)g * 65536, nullptr, 256, 256, (bf16_t*)(ws + OFF_WPT) + (size_t)g * 65536, nullptr, scr, r & 31, 8, lane, p.in[16] + g * 256); continue; } r -= I_POOL;
        if (r < I_OUT) { tr_item<0>(p.in[17], nullptr, 1024, 1024, (bf16_t*)(ws + OFF_WOUT), nullptr, scr, r, 32, lane); continue; } r -= I_OUT;
        if (r < I_PG) { tr_item<0>(p.in[23], nullptr, 1024, 1024, (bf16_t*)(ws + OFF_WPG), p.in[22], scr, r, 32, lane); continue; } r -= I_PG;
        tr_item<0>(p.in[24], nullptr, 1024, 256, (bf16_t*)(ws + OFF_WPP), nullptr, scr, r, 32, lane);
    }
}
__device__ __forceinline__ void phase_prep(const Params& p, LAS unsigned char* lds) {
    const int tid = threadIdx.x, lane = tid & 63, wave = tid >> 6; const int gw = blockIdx.x * 8 + wave, NGW = gridDim.x * 8;
    LAS float* scr = (LAS float*)(lds + wave * 16384);
    unsigned char* ws = p.ws;
    conv_ffn(p, 6, (bf16_t*)(ws + OFF_WFFN), scr, gw, NGW, lane);
    bf16_t* xb = (bf16_t*)(ws + OFF_HB); float* ssa = (float*)(ws + OFF_SSA); bf16_t* pb = (bf16_t*)(ws + OFF_PB);
    for (int row0 = gw; row0 < M; row0 += 2 * NGW) {
        f32x4 v[2][4], pv[2]; float sx[2];
#pragma unroll
        for (int e = 0; e < 2; ++e) { const int row = row0 + e * NGW; if (row < M) {
            const float* xr = (row < MP) ? p.in[0] + (size_t)row * 1024 : p.in[1] + (size_t)(row - MP) * 1024;
            const float* pr = (row < MP) ? p.in[2] + (size_t)row * 256 : p.in[3] + (size_t)(row - MP) * 256;
#pragma unroll
            for (int j = 0; j < 4; ++j) v[e][j] = *(const f32x4*)(xr + j * 256 + lane * 4);
            pv[e] = *(const f32x4*)(pr + lane * 4); } }
#pragma unroll
        for (int e = 0; e < 2; ++e) { const int row = row0 + e * NGW; if (row < M) { float s_ = 0.f;
#pragma unroll
            for (int j = 0; j < 4; ++j) s_ += (v[e][j][0] * v[e][j][0] + v[e][j][1] * v[e][j][1]) + (v[e][j][2] * v[e][j][2] + v[e][j][3] * v[e][j][3]);
            sx[e] = wave_sum(s_);
#pragma unroll
            for (int j = 0; j < 4; ++j) *(u32x2*)(xb + (size_t)row * 1024 + j * 256 + lane * 4) = pack4(v[e][j]);
            if (lane < 16) ssa[(size_t)row * 16 + lane] = (lane == 0) ? sx[e] : 0.f;
            *(u32x2*)(pb + (size_t)row * 256 + lane * 4) = pack4(pv[e]); } }
    }
}

__device__ __forceinline__ float logsig16(float x) { return (fminf(x, 0.f) - __logf(1.0f + __expf(-fabsf(x)))) * 0.0625f; }
struct PrepPf { f32x4 gk; u32x4 v[4], q[2], k[2]; };
__device__ __forceinline__ void prep_prefetch(const Params& p, int item, PrepPf& pf) {
    const bf16_t* zA = (const bf16_t*)(p.ws + OFF_BIG); const float* gklr = (const float*)(p.ws + OFF_GKLR);
    const int b = item >> 7, n = (item >> 2) & 31, h = item & 3, r0 = b * 2048 + n * 64, tid = threadIdx.x;
    pf.gk = (f32x4){0.f, 0.f, 0.f, 0.f};
    if (tid < 256) pf.gk = *(const f32x4*)(gklr + (size_t)r0 * 16 + tid * 4);
#pragma unroll
    for (int x = 0; x < 4; ++x) { const int q = tid + 512 * x, row = q >> 5, cc = q & 31; pf.v[x] = *(const u32x4*)(zA + (size_t)(r0 + row) * ZLD + 2048 + h * 256 + cc * 8); }
#pragma unroll
    for (int x = 0; x < 2; ++x) { const int q = tid + 512 * x, row = q >> 4, cc = q & 15;
        pf.q[x] = *(const u32x4*)(zA + (size_t)(r0 + row) * ZLD + 1024 + h * 128 + cc * 8); pf.k[x] = *(const u32x4*)(zA + (size_t)(r0 + row) * ZLD + 1536 + h * 128 + cc * 8); }
}
__device__ __forceinline__ void gla_prep_item(const Params& p, LAS unsigned char* lds, int item, PrepPf& pf, int next_item) {
    unsigned char* ws = p.ws; bf16_t* zA = (bf16_t*)(ws + OFF_BIG);
    bf16_t* At = (bf16_t*)(ws + OFF_AT); float* decl = (float*)(ws + OFF_DECL);
    const int b = item >> 7, n = (item >> 2) & 31, h = item & 3, r0 = b * 2048 + n * 64;
    const int tid = threadIdx.x, cch = tid & 127, jq = tid >> 7, lane = tid & 63, wave = tid >> 6, fr = lane & 15, fq = lane >> 4;
    LAS float* gk_l = (LAS float*)lds; LAS float* tot = (LAS float*)(lds + 4096);
    LAS bf16_t* QL = (LAS bf16_t*)(lds + 6144); LAS bf16_t* KL = (LAS bf16_t*)(lds + 23552); LAS bf16_t* VL = (LAS bf16_t*)(lds + 40960);
    if (tid < 256) *(LAS f32x4*)(gk_l + tid * 4) = pf.gk;
#pragma unroll
    for (int x = 0; x < 4; ++x) { const int q = tid + 512 * x, row = q >> 5, cc = q & 31; *(LAS u32x4*)(VL + row * 264 + cc * 8) = pf.v[x]; }
#pragma unroll
    for (int x = 0; x < 2; ++x) { const int q = tid + 512 * x, row = q >> 4, cc = q & 15; *(LAS u32x4*)(QL + row * 136 + cc * 8) = pf.q[x]; *(LAS u32x4*)(KL + row * 136 + cc * 8) = pf.k[x]; }
    float bl[16]; float run = 0.f;
    { float wup[16];
#pragma unroll
      for (int i = 0; i < 16; ++i) wup[i] = p.in[12][i * 512 + h * 128 + cch];
      const float bg = p.in[13][h * 128 + cch];
      asm volatile("s_waitcnt vmcnt(0) lgkmcnt(0)" ::: "memory");
      __syncthreads();
#pragma unroll
      for (int i = 0; i < 16; ++i) { const int j = jq * 16 + i; float x = bg;
#pragma unroll
        for (int r = 0; r < 16; ++r) x += gk_l[j * 16 + r] * wup[r];
        run += logsig16(x); bl[i] = run; } }
    tot[jq * 128 + cch] = run;
    __syncthreads();
    float pre = 0.f, blast = 0.f;
#pragma unroll
    for (int q = 0; q < 4; ++q) { const float t = tot[q * 128 + cch]; blast += t; if (q < jq) pre += t; }
    unsigned kd[8];
#pragma unroll
    for (int i = 0; i < 16; i += 2) { float kdv[2];
#pragma unroll
        for (int e = 0; e < 2; ++e) { const int ii = i + e, j = jq * 16 + ii; const float bb = bl[ii] + pre; const float qraw = bf1(QL[j * 136 + cch]), kraw = bf1(KL[j * 136 + cch]);
            const float qt = qraw * __expf(bb), kt = kraw * __expf(-bb); kdv[e] = kraw * __expf(blast - bb);
            QL[j * 136 + cch] = f2bf(qt); KL[j * 136 + cch] = f2bf(kt); }
        kd[i >> 1] = cvt_pk_bf16(kdv[0], kdv[1]); }
    if (jq == 0) decl[(size_t)item * 128 + cch] = __expf(blast);
    { bf16_t* dst = zA + (size_t)(r0 + (cch >> 1)) * ZLD + 1536 + h * 128 + (cch & 1) * 64 + jq * 16;
      *(u32x4*)dst = (u32x4){kd[0], kd[1], kd[2], kd[3]}; *(u32x4*)(dst + 8) = (u32x4){kd[4], kd[5], kd[6], kd[7]}; }
    __syncthreads();
#pragma unroll
    for (int x = 0; x < 2; ++x) { const int q = tid + 512 * x, row = q >> 4, cc = q & 15;
        *(u32x4*)(zA + (size_t)(r0 + row) * ZLD + 1024 + h * 128 + cc * 8) = *(const LAS u32x4*)(QL + row * 136 + cc * 8); }
    { const int tt = wave >> 1;
#pragma unroll
      for (int x = 0; x < 2; ++x) { const int jt = (wave & 1) * 2 + x; f32x4 a = (f32x4){0.f, 0.f, 0.f, 0.f};
        if (jt <= tt) {
#pragma unroll
            for (int ks = 0; ks < 4; ++ks) { const bf16x8 xk = *(const LAS bf16x8*)(KL + (16 * jt + fr) * 136 + 32 * ks + 8 * fq), yq = *(const LAS bf16x8*)(QL + (16 * tt + fr) * 136 + 32 * ks + 8 * fq);
                a = __builtin_amdgcn_mfma_f32_16x16x32_bf16(xk, yq, a, 0, 0, 0); } }
        const int t = 16 * tt + fr, j0 = 16 * jt + 4 * fq;
#pragma unroll
        for (int r = 0; r < 4; ++r) if (j0 + r > t) a[r] = 0.f;
        *(u32x2*)(At + (size_t)item * 4096 + t * 64 + j0) = pack4(a); } }
#pragma unroll
    for (int x = 0; x < 2; ++x) { const int pi = tid + 512 * x, vv = pi >> 2, j2 = pi & 3; unsigned w[8];
#pragma unroll
        for (int i = 0; i < 8; ++i) { const unsigned lo = VL[(j2 * 16 + 2 * i) * 264 + vv], hi = VL[(j2 * 16 + 2 * i + 1) * 264 + vv]; w[i] = lo | (hi << 16); }
        bf16_t* dst = zA + (size_t)(r0 + (vv >> 2)) * ZLD + 2048 + h * 256 + (vv & 3) * 64 + j2 * 16;
        *(u32x4*)dst = (u32x4){w[0], w[1], w[2], w[3]}; *(u32x4*)(dst + 8) = (u32x4){w[4], w[5], w[6], w[7]}; }
    if (next_item >= 0) prep_prefetch(p, next_item, pf);
    __syncthreads();
}
template <int W>
__device__ __forceinline__ void pool_tile(const bf16_t* zA, bf16_t* pooled, size_t rb, int t0, int c0) {
    unsigned prev[16], cur[16];
#pragma unroll
    for (int i = 0; i < 16; ++i) { const int tt = t0 - 16 + i; prev[i] = (tt >= 0) ? *(const unsigned*)(zA + (rb + tt) * ZLD + c0) : 0u; }
    float s0 = 0.f, s1 = 0.f;
#pragma unroll
    for (int i = 17 - W; i < 16; ++i) { s0 += bf_lo(prev[i]); s1 += bf_hi(prev[i]); }
#pragma unroll 1
    for (int blk = 0; blk < 4; ++blk) { const int tb = t0 + blk * 16;
#pragma unroll
        for (int i = 0; i < 16; ++i) cur[i] = *(const unsigned*)(zA + (rb + tb + i) * ZLD + c0);
#pragma unroll
        for (int i = 0; i < 16; ++i) { const float u0 = bf_lo(cur[i]), u1 = bf_hi(cur[i]); s0 += u0; s1 += u1; const int t = tb + i;
            const float ic = 1.0f / (float)((t + 1 < W) ? (t + 1) : W);
            *(unsigned*)(pooled + (rb + t) * 1024 + c0) = cvt_pk_bf16(s0 * ic - u0, s1 * ic - u1);
            const int k = i - W + 1; const unsigned d = (k >= 0) ? cur[k >= 0 ? k : 0] : prev[k >= 0 ? 0 : 16 + k]; s0 -= bf_lo(d); s1 -= bf_hi(d); }
#pragma unroll
        for (int i = 0; i < 16; ++i) prev[i] = cur[i]; }
}
__device__ __forceinline__ void pool_prompt_item(const Params& p, int item) {
    unsigned char* ws = p.ws; const bf16_t* zA = (const bf16_t*)(ws + OFF_BIG); bf16_t* pooled = (bf16_t*)p.out;
    const int b = item >> 5, n = item & 31, tid = threadIdx.x, c0 = 2 * tid, g = c0 >> 8, t0 = n * 64; const size_t rb = (size_t)b * 2048;
    if (g == 0) pool_tile<2>(zA, pooled, rb, t0, c0); else if (g == 1) pool_tile<4>(zA, pooled, rb, t0, c0); else if (g == 2) pool_tile<8>(zA, pooled, rb, t0, c0); else pool_tile<16>(zA, pooled, rb, t0, c0);
    if (n == 31) { float* np = p.out + OUT_NPP + (size_t)b * 15 * 1024;
#pragma unroll
        for (int i = 0; i < 15; ++i) { const unsigned v = *(const unsigned*)(zA + (rb + 2033 + i) * ZLD + c0); *(f32x2*)(np + i * 1024 + c0) = (f32x2){bf_lo(v), bf_hi(v)}; } }
}
template <int W>
__device__ __forceinline__ void pool_sample_w(const float (&e0)[19], const float (&e1)[19], bf16_t* prow, int c0) {
#pragma unroll
    for (int t = 0; t < 4; ++t) { float s0 = 0.f, s1 = 0.f;
#pragma unroll
        for (int r = 15 + t - W + 1; r <= 15 + t; ++r) { s0 += e0[r]; s1 += e1[r]; }
        *(unsigned*)(prow + (size_t)t * 1024 + c0) = cvt_pk_bf16(s0 * (1.0f / W) - e0[15 + t], s1 * (1.0f / W) - e1[15 + t]); }
}
__device__ __forceinline__ void pool_sample_item(const Params& p, int b) {
    unsigned char* ws = p.ws; const bf16_t* zA = (const bf16_t*)(ws + OFF_BIG); bf16_t* pooled = (bf16_t*)p.out;
    const int tid = threadIdx.x, c0 = 2 * tid, g = c0 >> 8; const float* sp = p.in[4] + (size_t)b * 15 * 1024; const size_t r0 = (size_t)MP + b * 4;
    float e0[19], e1[19];
#pragma unroll
    for (int r = 0; r < 15; ++r) { const f32x2 v = *(const f32x2*)(sp + r * 1024 + c0); e0[r] = v[0]; e1[r] = v[1]; }
#pragma unroll
    for (int t = 0; t < 4; ++t) { const unsigned v = *(const unsigned*)(zA + (r0 + t) * ZLD + c0); e0[15 + t] = bf_lo(v); e1[15 + t] = bf_hi(v); }
    bf16_t* prow = pooled + r0 * 1024;
    if (g == 0) pool_sample_w<2>(e0, e1, prow, c0); else if (g == 1) pool_sample_w<4>(e0, e1, prow, c0); else if (g == 2) pool_sample_w<8>(e0, e1, prow, c0); else pool_sample_w<16>(e0, e1, prow, c0);
    float* np = p.out + OUT_NPS + (size_t)b * 15 * 1024;
#pragma unroll
    for (int i = 0; i < 15; ++i) *(f32x2*)(np + i * 1024 + c0) = (f32x2){e0[i + 4], e1[i + 4]};
}

constexpr int RB_Q = 0, RB_K = 17408, RB_A = 35840, RB_V = 45056, RB_D = 63488, RB_SZ = 65536;
__device__ __forceinline__ void gla_rec_item(const Params& p, LAS unsigned char* lds, int item) {
    unsigned char* ws = p.ws; bf16_t* zA = (bf16_t*)(ws + OFF_BIG); const bf16_t* At = (const bf16_t*)(ws + OFF_AT); const float* decl = (const float*)(ws + OFF_DECL); float* oss = (float*)(ws + OFF_OSS);
    const int quarter = item & 3, h = (item >> 2) & 3, b = item >> 4;
    const int tid = threadIdx.x, lane = tid & 63, wave = tid >> 6, fr = lane & 15, fq = lane >> 4;
    f32x4 S[8];
#pragma unroll
    for (int i = 0; i < 8; ++i) S[i] = (f32x4){0.f, 0.f, 0.f, 0.f};
    u32x4 rqA[2], rkA[2], raA, rvA, rqB[2], rkB[2], raB, rvB; f32x4 rdA = (f32x4){0.f, 0.f, 0.f, 0.f}, rdB = (f32x4){0.f, 0.f, 0.f, 0.f};
#define REC_LOAD(T, nn) do { const int r0_ = b * 2048 + (nn) * 64; const size_t it_ = (size_t)((b * 32 + (nn)) * 4 + h); \
        _Pragma("unroll") for (int x = 0; x < 2; ++x) { const int id = tid + 512 * x; \
            rq##T[x] = *(const u32x4*)(zA + (size_t)(r0_ + (id >> 4)) * ZLD + 1024 + h * 128 + (id & 15) * 8); \
            rk##T[x] = *(const u32x4*)(zA + (size_t)(r0_ + (id >> 4)) * ZLD + 1536 + h * 128 + (id & 15) * 8); \
            } \
        rv##T = *(const u32x4*)(zA + (size_t)(r0_ + 16 * quarter + (tid >> 5)) * ZLD + 2048 + h * 256 + (tid & 31) * 8); \
        ra##T = *(const u32x4*)(At + it_ * 4096 + (tid >> 3) * 64 + (tid & 7) * 8); \
        if (tid < 32) rd##T = *(const f32x4*)(decl + it_ * 128 + tid * 4); } while (0)
#define REC_STORE(T, buf) do { LAS unsigned char* B_ = lds + (buf) * RB_SZ; \
        _Pragma("unroll") for (int x = 0; x < 2; ++x) { const int id = tid + 512 * x; \
            *(LAS u32x4*)(B_ + RB_Q + (id >> 4) * 272 + (id & 15) * 16) = rq##T[x]; \
            *(LAS u32x4*)(B_ + RB_K + (2 * (id >> 4) + ((id & 15) >> 3)) * 144 + (id & 7) * 16) = rk##T[x]; \
            } \
        *(LAS u32x4*)(B_ + RB_V + (4 * (tid >> 5) + ((tid & 31) >> 3)) * 144 + (tid & 7) * 16) = rv##T; \
        *(LAS u32x4*)(B_ + RB_A + (tid >> 3) * 144 + (tid & 7) * 16) = ra##T; \
        if (tid < 32) *(LAS f32x4*)(B_ + RB_D + tid * 16) = rd##T; } while (0)
#define REC_STEP(n) do { \
        const LAS unsigned char* B = lds + ((n) & 1) * RB_SZ; const int r0 = b * 2048 + (n) * 64; \
        bf16x8 vt[2]; u32x2 qf[4][4][2]; bf16x8 af[4][2]; \
        _Pragma("unroll") for (int jk = 0; jk < 2; ++jk) vt[jk] = *(const LAS bf16x8*)(B + RB_V + (16 * wave + fr) * 144 + (32 * jk + 8 * fq) * 2); \
        _Pragma("unroll") for (int tt = 0; tt < 4; ++tt) { \
            _Pragma("unroll") for (int cp = 0; cp < 4; ++cp) { const LAS unsigned char* qa = B + RB_Q + (16 * tt + fr) * 272 + (32 * cp + 4 * fq) * 2; qf[tt][cp][0] = *(const LAS u32x2*)qa; qf[tt][cp][1] = *(const LAS u32x2*)(qa + 32); } \
            _Pragma("unroll") for (int jk = 0; jk < 2; ++jk) af[tt][jk] = *(const LAS bf16x8*)(B + RB_A + (16 * tt + fr) * 144 + (32 * jk + 8 * fq) * 2); } \
        bf16x8 sop[4]; \
        _Pragma("unroll") for (int cp = 0; cp < 4; ++cp) { u32x4 w; w.x = cvt_pk_bf16(S[2 * cp][0], S[2 * cp][1]); w.y = cvt_pk_bf16(S[2 * cp][2], S[2 * cp][3]); w.z = cvt_pk_bf16(S[2 * cp + 1][0], S[2 * cp + 1][1]); w.w = cvt_pk_bf16(S[2 * cp + 1][2], S[2 * cp + 1][3]); \
            sop[cp] = __builtin_bit_cast(bf16x8, w); } \
        f32x4 o[4]; \
        _Pragma("unroll") for (int tt = 0; tt < 4; ++tt) o[tt] = (f32x4){0.f, 0.f, 0.f, 0.f}; \
        _Pragma("unroll") for (int cp = 0; cp < 4; ++cp) \
            _Pragma("unroll") for (int tt = 0; tt < 4; ++tt) { const u32x4 qw = (u32x4){qf[tt][cp][0].x, qf[tt][cp][0].y, qf[tt][cp][1].x, qf[tt][cp][1].y}; \
                o[tt] = __builtin_amdgcn_mfma_f32_16x16x32_bf16(sop[cp], __builtin_bit_cast(bf16x8, qw), o[tt], 0, 0, 0); } \
        _Pragma("unroll") for (int jk = 0; jk < 2; ++jk) \
            _Pragma("unroll") for (int tt = 0; tt < 4; ++tt) o[tt] = __builtin_amdgcn_mfma_f32_16x16x32_bf16(vt[jk], af[tt][jk], o[tt], 0, 0, 0); \
        __builtin_amdgcn_sched_barrier(0); \
        _Pragma("unroll") for (int tt = 0; tt < 4; ++tt) { const int row = r0 + 16 * tt + fr; \
            *(u32x2*)(zA + (size_t)row * ZLD + h * 256 + quarter * 64 + wave * 16 + 4 * fq) = pack4(o[tt]); \
            float sq = (o[tt][0] * o[tt][0] + o[tt][1] * o[tt][1]) + (o[tt][2] * o[tt][2] + o[tt][3] * o[tt][3]); sq += __shfl_xor(sq, 16); sq += __shfl_xor(sq, 32); \
            if (fq == 0) oss[(size_t)row * 64 + h * 16 + quarter * 4 + wave] = sq; } \
        _Pragma("unroll") for (int hf = 0; hf < 2; ++hf) { bf16x8 kf[4][2]; f32x4 dv[4]; \
            _Pragma("unroll") for (int c4 = 0; c4 < 4; ++c4) { const int ct = hf * 4 + c4; dv[c4] = *(const LAS f32x4*)(B + RB_D + (16 * ct + 4 * fq) * 4); \
                _Pragma("unroll") for (int jk = 0; jk < 2; ++jk) kf[c4][jk] = *(const LAS bf16x8*)(B + RB_K + (16 * ct + fr) * 144 + (32 * jk + 8 * fq) * 2); } \
            _Pragma("unroll") for (int c4 = 0; c4 < 4; ++c4) S[hf * 4 + c4] = S[hf * 4 + c4] * dv[c4]; \
            _Pragma("unroll") for (int jk = 0; jk < 2; ++jk) \
                _Pragma("unroll") for (int c4 = 0; c4 < 4; ++c4) S[hf * 4 + c4] = __builtin_amdgcn_mfma_f32_16x16x32_bf16(kf[c4][jk], vt[jk], S[hf * 4 + c4], 0, 0, 0); \
            __builtin_amdgcn_sched_barrier(0); } \
        } while (0)
    REC_LOAD(A, 0); REC_STORE(A, 0); REC_LOAD(B, 1);
    __syncthreads();
#pragma unroll 1
    for (int n = 0; n < 32; n += 2) {
        if (n + 2 < 32) REC_LOAD(A, n + 2);
        if (wave < 4) REC_STEP(n);
        REC_STORE(B, 1);
        __syncthreads();
        if (n + 3 < 32) REC_LOAD(B, n + 3);
        if (wave < 4) REC_STEP(n + 1);
        if (n + 2 < 32) REC_STORE(A, 0);
        __syncthreads();
    }
#undef REC_LOAD
#undef REC_STORE
#undef REC_STEP
    if (wave >= 4) return;
    float* so = p.out + OUT_NGP + (size_t)(b * 4 + h) * 128 * 256 + quarter * 64 + wave * 16 + fr;
#pragma unroll
    for (int ct = 0; ct < 8; ++ct)
#pragma unroll
        for (int r = 0; r < 4; ++r) so[(size_t)(16 * ct + 4 * fq + r) * 256] = S[ct][r];
}
__device__ __forceinline__ void gla_sample_item(const Params& p, LAS unsigned char* lds, int item) {
    unsigned char* ws = p.ws; bf16_t* zA = (bf16_t*)(ws + OFF_BIG); const float* gklr = (const float*)(ws + OFF_GKLR); float* oss = (float*)(ws + OFF_OSS);
    const int b = item >> 2, h = item & 3, r0 = MP + b * 4; const int tid = threadIdx.x, lane = tid & 63, wave = tid >> 6;
    LAS float* qe = (LAS float*)lds;
    LAS float* ke = qe + 512;
    LAS float* dl = ke + 512;
    LAS float* Ap = dl + 128;
    LAS float* vl = Ap + 32;
    LAS float* op = vl + 1024;
    for (int i = tid; i < 1024; i += 512) vl[i] = bf1(zA[(size_t)(r0 + (i >> 8)) * ZLD + 2048 + h * 256 + (i & 255)]);
    LAS float* gkl = op;
    if (tid >= 448) gkl[tid - 448] = gklr[(size_t)r0 * 16 + (tid - 448)];
    __syncthreads();
    if (tid < 128) { const int c = tid; float bl[4], qv[4], kv[4]; float run = 0.f; const float bg = p.in[13][h * 128 + c];
        float wup[16];
#pragma unroll
        for (int r = 0; r < 16; ++r) wup[r] = p.in[12][r * 512 + h * 128 + c];
#pragma unroll
        for (int t = 0; t < 4; ++t) { float x = bg;
#pragma unroll
            for (int r = 0; r < 16; ++r) x += gkl[t * 16 + r] * wup[r];
            run += logsig16(x); bl[t] = run; qv[t] = bf1(zA[(size_t)(r0 + t) * ZLD + 1024 + h * 128 + c]); kv[t] = bf1(zA[(size_t)(r0 + t) * ZLD + 1536 + h * 128 + c]); }
#pragma unroll
        for (int t = 0; t < 4; ++t) { qe[t * 128 + c] = qv[t] * __expf(bl[t]); ke[t * 128 + c] = kv[t] * __expf(bl[3] - bl[t]); }
        dl[c] = __expf(bl[3]);
#pragma unroll
        for (int i = 0; i < 4; ++i)
#pragma unroll
            for (int j = 0; j < 4; ++j) { float v = (j <= i) ? qv[i] * kv[j] * __expf(bl[i] - bl[j]) : 0.f; v = wave_sum(v); if (lane == 0) Ap[wave * 16 + i * 4 + j] = v; }
    }
    __syncthreads();
    const int vq = tid & 63, cp = tid >> 6;
    const float* S0 = p.in[5] + (size_t)item * 128 * 256; float* Sn = p.out + OUT_NGS + (size_t)item * 128 * 256;
    f32x4 vv[4];
#pragma unroll
    for (int j = 0; j < 4; ++j) vv[j] = *(const LAS f32x4*)(vl + j * 256 + vq * 4);
    f32x4 oa[4];
#pragma unroll
    for (int i = 0; i < 4; ++i) oa[i] = (f32x4){0.f, 0.f, 0.f, 0.f};
#pragma unroll 1
    for (int c8 = 0; c8 < 2; ++c8) {
    f32x4 s0r[8];
#pragma unroll
    for (int cc = 0; cc < 8; ++cc) s0r[cc] = __builtin_nontemporal_load((const f32x4*)(S0 + (size_t)(cp * 16 + c8 * 8 + cc) * 256 + vq * 4));
#pragma unroll
    for (int cc = 0; cc < 8; ++cc) { const int c = cp * 16 + c8 * 8 + cc; const f32x4 s = s0r[cc];
        f32x4 sn = s * dl[c];
#pragma unroll
        for (int j = 0; j < 4; ++j) sn += vv[j] * ke[j * 128 + c];
        *(f32x4*)(Sn + (size_t)c * 256 + vq * 4) = sn;
#pragma unroll
        for (int i = 0; i < 4; ++i) oa[i] += s * qe[i * 128 + c]; }
    }
#pragma unroll
    for (int i = 0; i < 4; ++i) *(LAS f32x4*)(op + (cp * 4 + i) * 256 + vq * 4) = oa[i];
    __syncthreads();
    if (tid < 256) { const int i = tid >> 6; f32x4 o = (f32x4){0.f, 0.f, 0.f, 0.f};
#pragma unroll
        for (int q = 0; q < 8; ++q) o += *(const LAS f32x4*)(op + (q * 4 + i) * 256 + vq * 4);
#pragma unroll
        for (int j = 0; j < 4; ++j) if (j <= i) o += vv[j] * (Ap[i * 4 + j] + Ap[16 + i * 4 + j]);
        *(u32x2*)(zA + (size_t)(r0 + i) * ZLD + h * 256 + vq * 4) = pack4(o);
        float sq = (o[0] * o[0] + o[1] * o[1]) + (o[2] * o[2] + o[3] * o[3]); sq = wave_sum(sq);
        if (lane < 16) oss[(size_t)(r0 + i) * 64 + h * 16 + lane] = (lane == 0) ? sq : 0.f; }
    __syncthreads();
}

__device__ __forceinline__ void conv_ffn2_idle(const Params& p, LAS unsigned char* lds, int G, int bid, int part, int nbusy) {
    if (bid < nbusy) return;
    const int tid = threadIdx.x; conv_ffn(p, 18, (bf16_t*)((unsigned char*)p.out + Y_FFN2_OFF), (LAS float*)(lds + (tid >> 6) * 16384), (bid - nbusy) * 8 + (tid >> 6), (G - nbusy) * 8, tid & 63, part);
}


template <class SE>
__device__ __forceinline__ void sample_gemm(const bf16_t* A, int lda, int a_pn_off, const bf16_t* Bt, int ldb, int K, int piece, const SE& E, LAS unsigned char* lds) {
    const int tid = threadIdx.x, lane = tid & 63, w8 = tid >> 6, w = w8 & 3, kh = w8 >> 2, mi = w >> 1, gi = w & 1, fr = lane & 15, fq = lane >> 4;
    const int mt2 = piece >> 4, cch = piece & 15, pn = cch >> 2, grp = 2 * (cch & 3) + gi;
    const int row = MP + 32 * mt2 + 16 * mi + fr, Kh = K >> 1;
    const bf16_t* ap = A + (size_t)row * lda + pn * a_pn_off + kh * Kh + 8 * fq;
    const bf16_t* bp0 = Bt + (size_t)(256 * pn + 32 * grp + fr) * ldb + kh * Kh + 8 * fq; const bf16_t* bp1 = bp0 + (size_t)16 * ldb;
    f32x4 acc0 = (f32x4){0.f, 0.f, 0.f, 0.f}, acc1 = (f32x4){0.f, 0.f, 0.f, 0.f};
    bf16x8 aA[4], b0A[4], b1A[4], aB[4], b0B[4], b1B[4];
#define SG_LD(T, kk) do { _Pragma("unroll") for (int j = 0; j < 4; ++j) { a##T[j] = *(const bf16x8*)(ap + (kk) + 32 * j); b0##T[j] = *(const bf16x8*)(bp0 + (kk) + 32 * j); b1##T[j] = *(const bf16x8*)(bp1 + (kk) + 32 * j); } } while (0)
#define SG_MM(T) do { _Pragma("unroll") for (int j = 0; j < 4; ++j) { acc0 = __builtin_amdgcn_mfma_f32_16x16x32_bf16(b0##T[j], a##T[j], acc0, 0, 0, 0); acc1 = __builtin_amdgcn_mfma_f32_16x16x32_bf16(b1##T[j], a##T[j], acc1, 0, 0, 0); } } while (0)
    SG_LD(A, 0);
#pragma unroll 1
    for (int k = 0; k < Kh; k += 256) {
        if (k + 128 < Kh) SG_LD(B, k + 128);
        SG_MM(A);
        if (k + 256 < Kh) SG_LD(A, k + 256);
        if (k + 128 < Kh) SG_MM(B);
    }
#undef SG_LD
#undef SG_MM
    LAS f32x4* xch = (LAS f32x4*)(lds + 4096);
    __syncthreads();
    if (kh == 1) { xch[(w * 64 + lane) * 2] = acc0; xch[(w * 64 + lane) * 2 + 1] = acc1; }
    __syncthreads();
    if (kh == 0) { acc0 += xch[(w * 64 + lane) * 2]; acc1 += xch[(w * 64 + lane) * 2 + 1]; }
    E(kh == 0, row, 256 * pn + 32 * grp + 8 * fq, pn, cch & 3, w, fr, fq, acc0, acc1, lds);
}
__device__ __forceinline__ void sample_ss(bool act, float sq, int row, int pn, int slot, int w, int fr, int fq, float* ssw, LAS unsigned char* lds) {
    LAS float* t = (LAS float*)lds; sq += __shfl_xor(sq, 16); sq += __shfl_xor(sq, 32);
    __syncthreads();
    if (act && fq == 0) t[w * 16 + fr] = sq;
    __syncthreads();
    if (act && fq == 0 && (w & 1) == 0) ssw[(size_t)row * 16 + pn * 4 + slot] = t[w * 16 + fr] + t[(w + 1) * 16 + fr];
}
struct SEpiResid { bf16_t* hb; float* ssw; float scale;
    __device__ __forceinline__ void operator()(bool act, int row, int c0, int pn, int slot, int w, int fr, int fq, f32x4 a0, f32x4 a1, LAS unsigned char* lds) const {
        bf16_t* hp = hb + (size_t)row * 1024 + c0; f32x4 v0 = (f32x4){0.f, 0.f, 0.f, 0.f}, v1 = v0;
        if (act) { const u32x4 r = *(const u32x4*)hp; v0 = unpack_lo(r) + a0 * scale; v1 = unpack_hi(r) + a1 * scale; *(u32x4*)hp = pack8(v0, v1); }
        sample_ss(act, ((v0[0] * v0[0] + v0[1] * v0[1]) + (v0[2] * v0[2] + v0[3] * v0[3])) + ((v1[0] * v1[0] + v1[1] * v1[1]) + (v1[2] * v1[2] + v1[3] * v1[3])), row, pn, slot, w, fr, fq, ssw, lds);
    } };
struct SEpiMix { bf16_t* sga; const bf16_t* P; const bf16_t* o; const float* oss;
    __device__ __forceinline__ void operator()(bool act, int row, int c0, int pn, int slot, int w, int fr, int fq, f32x4 a0, f32x4 a1, LAS unsigned char* lds) const {
        if (!act) return;
        const float rso = 1.0f / sqrtf(sum16(oss + (size_t)row * 64 + pn * 16) * (1.0f / 256.0f) + EPS);
        bf16_t* sp = sga + (size_t)row * 1024 + c0; const u32x4 sg = *(const u32x4*)sp, pv = *(const u32x4*)(P + (size_t)row * 1024 + c0), ov = *(const u32x4*)(o + (size_t)row * ZLD + c0);
        *(u32x4*)sp = pack8(unpack_lo(sg) * a0 + unpack_lo(pv) * (unpack_lo(ov) * rso), unpack_hi(sg) * a1 + unpack_hi(pv) * (unpack_hi(ov) * rso));
    } };
struct SEpiBf16 { bf16_t* out;
    __device__ __forceinline__ void operator()(bool act, int row, int c0, int pn, int slot, int w, int fr, int fq, f32x4 a0, f32x4 a1, LAS unsigned char* lds) const { if (act) *(u32x4*)(out + (size_t)row * 1024 + c0) = pack8(a0, a1); } };
struct SEpiPle { float* h; const bf16_t* hb; const bf16_t* pp; const float* ss; float* ssw;
    __device__ __forceinline__ void operator()(bool act, int row, int c0, int pn, int slot, int w, int fr, int fq, f32x4 a0, f32x4 a1, LAS unsigned char* lds) const {
        f32x4 v0 = (f32x4){0.f, 0.f, 0.f, 0.f}, v1 = v0;
        if (act) { const float rs = rowscale(ss, row, 1.0f / 1024.0f); const u32x4 hv = *(const u32x4*)(hb + (size_t)row * 1024 + c0), pv = *(const u32x4*)(pp + (size_t)row * 1024 + c0);
            v0 = unpack_lo(hv) + sigmoid4(a0 * rs) * unpack_lo(pv); v1 = unpack_hi(hv) + sigmoid4(a1 * rs) * unpack_hi(pv);
            *(f32x4*)(h + (size_t)row * 1024 + c0) = v0; *(f32x4*)(h + (size_t)row * 1024 + c0 + 4) = v1; }
        sample_ss(act, ((v0[0] * v0[0] + v0[1] * v0[1]) + (v0[2] * v0[2] + v0[3] * v0[3])) + ((v1[0] * v1[0] + v1[1] * v1[1]) + (v1[2] * v1[2] + v1[3] * v1[3])), row, pn, slot, w, fr, fq, ssw, lds);
    } };

#define XB_TMO      128
#define XB_XCNT(j)  (256  + 64 * (j))
#define XB_XSUB(j)  (1280 + 64 * (j))
#define XB_XGEN(j)  (2304 + 64 * (j))
#define XB_TOP      3328
#define XB_TOPGEN   3392
#define XCD_BAR_WORDS 3456
#define XB_SPIN_CAP (1u << 18)
__device__ __forceinline__ unsigned xb_ld(unsigned* p)              { return __hip_atomic_load(p, __ATOMIC_RELAXED, __HIP_MEMORY_SCOPE_AGENT); }
__device__ __forceinline__ unsigned xb_add(unsigned* p, unsigned v) { return __hip_atomic_fetch_add(p, v, __ATOMIC_RELAXED, __HIP_MEMORY_SCOPE_AGENT); }
__device__ __forceinline__ unsigned xb_xcc_id() { return (unsigned)__builtin_amdgcn_s_getreg((3 << 11) | 20) & 0xFu; }
#define XB_SPIN(cond, bar) do { unsigned _sp = 0; while (cond) { __builtin_amdgcn_s_sleep(1); \
    if ((++_sp & 255u) == 0u) { if (xb_ld(&(bar)[XB_TMO])) break; if (_sp > XB_SPIN_CAP) { atomicAdd(&(bar)[XB_TMO], 1u); break; } } } } while (0)
struct XcdBarrier { unsigned* bar; unsigned x; volatile LAS unsigned* st; };
__device__ __forceinline__ XcdBarrier xcd_barrier_post(unsigned* bar, volatile LAS unsigned* st) {
    XcdBarrier b; b.bar = bar; b.x = xb_xcc_id(); b.st = st;
    if (threadIdx.x == 0) (void)xb_add(&bar[XB_XCNT(b.x)], 1u);
    return b;
}
__device__ __forceinline__ void xcd_barrier_complete(unsigned* bar, unsigned x, unsigned& nloc, unsigned& nx) {
    const unsigned G = gridDim.x * gridDim.y * gridDim.z;
    unsigned sum, cnt, mine, sp = 0u;
    for (;;) {
        sum = 0u; cnt = 0u; mine = 0u;
#pragma unroll
        for (unsigned j = 0; j < 16; ++j) { const unsigned c = xb_ld(&bar[XB_XCNT(j)]); sum += c; cnt += (c > 0u) ? 1u : 0u; mine = (j == x) ? c : mine; }
        if (sum == G) break;
        __builtin_amdgcn_s_sleep(1);
        if ((++sp & 255u) == 0u) { if (xb_ld(&bar[XB_TMO])) break; if (sp > XB_SPIN_CAP) { atomicAdd(&bar[XB_TMO], 1u); break; } }
    }
    nloc = mine > 0u ? mine : 1u; nx = cnt > 0u ? cnt : 1u;
}
__device__ __forceinline__ void xcd_barrier(const XcdBarrier& b) {
    asm volatile("s_waitcnt vmcnt(0)" ::: "memory");
    __syncthreads();
    if (threadIdx.x == 0) {
        unsigned* bar = b.bar;
        __builtin_amdgcn_s_waitcnt(0);
        unsigned nloc = b.st[0], nx = b.st[1];
        if (nloc == 0u) { xcd_barrier_complete(bar, b.x, nloc, nx); b.st[0] = nloc; b.st[1] = nx; }
        const unsigned old = xb_add(&bar[XB_XSUB(b.x)], 1u);
        const unsigned gen = old / nloc;
        if (old + 1u == (gen + 1u) * nloc) {
            __builtin_amdgcn_fence(__ATOMIC_RELEASE, "agent");
            asm volatile("s_waitcnt vmcnt(0)" ::: "memory");
            const unsigned og = xb_add(&bar[XB_TOP], 1u);
            const unsigned tg = og / nx;
            if (og + 1u == (tg + 1u) * nx) xb_add(&bar[XB_TOPGEN], 1u);
            else XB_SPIN(xb_ld(&bar[XB_TOPGEN]) == tg, bar);
            __builtin_amdgcn_fence(__ATOMIC_ACQUIRE, "agent");
            xb_add(&bar[XB_XGEN(b.x)], 1u);
            asm volatile("s_waitcnt vmcnt(0)" ::: "memory");
        } else {
            XB_SPIN(xb_ld(&bar[XB_XGEN(b.x)]) == gen, bar);
            __builtin_amdgcn_fence(__ATOMIC_ACQUIRE, "agent");
            asm volatile("s_waitcnt vmcnt(0)" ::: "memory");
        }
    }
    __syncthreads();
}
__global__ void __launch_bounds__(512, 2) fwd_megakernel(Params p) {
    extern __shared__ __attribute__((aligned(16))) unsigned char lds_raw[];
    LAS unsigned char* lds = (LAS unsigned char*)lds_raw;
    cg::grid_group grid = cg::this_grid();
    unsigned char* ws = p.ws; const int G = gridDim.x, bid = blockIdx.x;
    bf16_t* hb = (bf16_t*)(ws + OFF_HB); bf16_t* big = (bf16_t*)(ws + OFF_BIG); bf16_t* sga = (bf16_t*)(ws + OFF_SGA); bf16_t* Pb = (bf16_t*)(ws + OFF_P);
    float* ssa = (float*)(ws + OFF_SSA); float* ssb = (float*)(ws + OFF_SSB); float* hres = p.out;
    const bf16_t* w1t = (const bf16_t*)(ws + OFF_WFFN); const bf16_t* w2t = (const bf16_t*)(ws + OFF_WFFN + SZ_W1T);
    const int lo = p.ph_lo, hi = p.ph_hi;
#ifndef PHMASK
#define PHMASK 0xFFF
#endif
#define IN(k) (((PHMASK >> (k)) & 1) && lo <= (k) && (k) < hi)
#define SEAM0() do { if (IN(0) && IN(1)) { asm volatile("s_waitcnt vmcnt(0) lgkmcnt(0)" ::: "memory"); grid.sync(); if (threadIdx.x < 64) { __builtin_amdgcn_fence(__ATOMIC_ACQUIRE, "agent"); asm volatile("s_waitcnt vmcnt(0)" ::: "memory"); } __syncthreads(); } } while (0)
#define SEAM(k) do { if (IN(k) && IN((k) + 1)) xcd_barrier(xbar); } while (0)
    unsigned* barw = (unsigned*)ws + 1024; volatile LAS unsigned* bst = (volatile LAS unsigned*)(lds + RS_OFF + 15360);
    if (threadIdx.x < 2) bst[threadIdx.x] = 0u;
    XcdBarrier xbar; xbar.bar = barw; xbar.x = 0; xbar.st = bst;
    if (lo == 0 && hi == NPH) xbar = xcd_barrier_post(barw, bst);
    if (lo < 0) grid.sync();
    if (IN(0)) phase_prep(p, lds);
    SEAM(0);
    if (IN(1)) { pg8::Gemm g{hb, w1t, 1024, 1024, 1024, 0}; pg8::StaticOrder S; S.init(M, 5632, G, bid); fill_rs(lds, S, ssa); EpiSwiglu E{big, (const LAS float*)(lds + RS_OFF)}; pg8::gemm_phase(lds, g, S, E);
        const int nb = (66 * 22) % G; if (bid >= nb) conv_rest(p, lds, (bid - nb) * 8 + (threadIdx.x >> 6), (G - nb) * 8); }
    SEAM(1);
    if (IN(2)) { pg8::Gemm g{big, w2t, FF, FF, FF, 0}; pg8::StaticOrder S; S.init(MP, 1024, G, bid); EpiResid E{hb, ssb, 0.5f}; pg8::gemm_phase(lds, g, S, E);
        for (int pc = bid; pc < 256; pc += G) { SEpiResid SE{hb, ssb, 0.5f}; sample_gemm(big, FF, 0, w2t, FF, FF, pc, SE, lds); }
    }
    SEAM(2);
    if (IN(3)) { pg8::Gemm g{hb, (const bf16_t*)(ws + OFF_WIN), 1024, 1024, 1024, 0}; pg8::StaticOrder S; S.init(M, NIN, G, bid);
        fill_rs(lds, S, ssb); EpiZ E{big, sga, Pb, (float*)(ws + OFF_GKLR), (const LAS float*)(lds + RS_OFF), p.in[14]}; pg8::gemm_phase(lds, g, S, E);
        conv_ffn2_idle(p, lds, G, bid, 0, (66 * 25) % G); }
    SEAM(3);
    if (IN(4)) {
        { PrepPf pf; if (bid < 1024) prep_prefetch(p, bid, pf);
          for (int it = bid; it < 1024; it += G) gla_prep_item(p, lds, it, pf, (it + G < 1024) ? it + G : -1); }
        int it0 = bid; while (it0 < 1024) it0 += G;
        for (int it = it0; it < 1024 + 256 + 128; it += G) {
            if (it < 1280) pool_prompt_item(p, it - 1024);
            else pool_sample_item(p, it - 1280);
        }
    }
    SEAM(4);
    if (IN(5)) {
        if (G >= 192) { if (bid < 128) gla_rec_item(p, lds, bid); else for (int it = bid - 128; it < 512; it += G - 128) gla_sample_item(p, lds, it); }
        else for (int it = bid; it < 640; it += G) { if (it < 128) gla_rec_item(p, lds, it); else gla_sample_item(p, lds, it - 128); }
    }
    SEAM(5);
    if (IN(6)) { pg8::Gemm g{(const bf16_t*)p.out, (const bf16_t*)(ws + OFF_WPT), 256, 1024, 256, 512}; pg8::StaticOrder S; S.init(MP, 1024, G, bid);
        fill_rso(lds, S, (const float*)(ws + OFF_OSS)); EpiMix E{sga, Pb, big, (const LAS float*)(lds + RS_OFF)}; pg8::gemm_phase(lds, g, S, E);
        for (int pc = bid; pc < 256; pc += G) { SEpiMix SE{sga, Pb, big, (const float*)(ws + OFF_OSS)}; sample_gemm((const bf16_t*)p.out, 1024, 256, (const bf16_t*)(ws + OFF_WPT), 256, 256, pc, SE, lds); }
    }
    SEAM(6);
    if (IN(7)) {
        pg8::Gemm g{sga, (const bf16_t*)(ws + OFF_WOUT), 1024, 1024, 1024, 0}; pg8::StaticOrder S; S.init(MP, 1024, G, bid);
        EpiResid E{hb, ssa, 1.0f}; pg8::gemm_phase(lds, g, S, E);
        for (int pc = bid; pc < 256; pc += G) { SEpiResid SE{hb, ssa, 1.0f}; sample_gemm(sga, 1024, 0, (const bf16_t*)(ws + OFF_WOUT), 1024, 1024, pc, SE, lds); }
    }
    SEAM(7);
    const bf16_t* w1t2 = (const bf16_t*)((const unsigned char*)p.out + Y_FFN2_OFF); const bf16_t* w2t2 = w1t2 + SZ_W1T / 2;
    if (IN(8)) { pg8::Gemm g{hb, w1t2, 1024, 1024, 1024, 0}; pg8::StaticOrder S; S.init(M, 5632, G, bid); fill_rs(lds, S, ssa); EpiSwiglu E{big, (const LAS float*)(lds + RS_OFF)}; pg8::gemm_phase(lds, g, S, E);
        const int nb = (66 * 22) % G; if (bid >= nb) { pg8::Gemm g2{(const bf16_t*)(ws + OFF_PB), (const bf16_t*)(ws + OFF_WPP), 256, 256, 256, 0}; pg8::StaticOrder S2; S2.init(MP, 1024, G - nb, bid - nb); EpiBf16 E2{Pb}; pg8::gemm_phase(lds, g2, S2, E2); } }
    SEAM(8);
    if (IN(9)) {
        { pg8::Gemm g{big, w2t2, FF, FF, FF, 0}; pg8::StaticOrder S; S.init(MP, 1024, G, bid); EpiResid E{hb, ssb, 0.5f}; pg8::gemm_phase(lds, g, S, E); }
        for (int pc = bid; pc < 256; pc += G) { SEpiResid SE{hb, ssb, 0.5f}; sample_gemm(big, FF, 0, w2t2, FF, FF, pc, SE, lds); }
        for (int pc = G - 1 - bid; pc < 256; pc += G) { SEpiBf16 SE{Pb}; sample_gemm((const bf16_t*)(ws + OFF_PB), 256, 0, (const bf16_t*)(ws + OFF_WPP), 256, 256, pc, SE, lds); }
    }
    SEAM(9);
    if (IN(10)) { pg8::Gemm g{hb, (const bf16_t*)(ws + OFF_WPG), 1024, 1024, 1024, 0}; pg8::StaticOrder S; S.init(MP, 1024, G, bid); fill_rs(lds, S, ssb); EpiPle E{hres, hb, Pb, (const LAS float*)(lds + RS_OFF), ssa}; pg8::gemm_phase(lds, g, S, E);
        for (int pc = bid; pc < 256; pc += G) { SEpiPle SE{hres, hb, Pb, ssb, ssa}; sample_gemm(hb, 1024, 0, (const bf16_t*)(ws + OFF_WPG), 1024, 1024, pc, SE, lds); } }
    SEAM(10);
    if (IN(11)) {
        const int tid = threadIdx.x, lane = tid & 63, gw = bid * 8 + (tid >> 6), NGW = G * 8;
        for (int row = gw; row < M; row += NGW) { const float rs = rowscale(ssa, row, 1.0f / 1024.0f); float* hr = hres + (size_t)row * 1024;
#pragma unroll
            for (int j = 0; j < 4; ++j) { const f32x4 v = *(const f32x4*)(hr + j * 256 + lane * 4); const f32x4 fn = *(const f32x4*)(p.in[25] + j * 256 + lane * 4); *(f32x4*)(hr + j * 256 + lane * 4) = v * rs * fn; } }
    }

#ifdef DUMP
    { asm volatile("s_waitcnt vmcnt(0) lgkmcnt(0)" ::: "memory"); grid.sync(); __builtin_amdgcn_fence(__ATOMIC_ACQUIRE, "agent"); asm volatile("s_waitcnt vmcnt(0)" ::: "memory");
      const size_t n = (size_t)M * 1024;
      for (size_t i = (size_t)bid * 512 + threadIdx.x; i < n; i += (size_t)G * 512) { const size_t row = i >> 10, col = i & 1023;
#if DUMP == 1
        hres[i] = bf1(sga[i]);
#elif DUMP == 2
        hres[i] = bf1(hb[i]); (void)row; (void)col;
#elif DUMP == 3
        hres[i] = bf1(Pb[i]); if (row < MP) p.out[OUT_NGS + i] = ((const float*)(ws + OFF_OSS))[row * 64 + (col & 63)];
#endif
      } }
#endif
#undef IN
#undef SEAM
}


#ifndef MK_SPLIT
#define MK_SPLIT 0
#endif
extern "C" void kernel_launch(void* const* d_in, const int* in_sizes, int n_in, void* d_out, int out_size, void* d_ws, size_t ws_size, hipStream_t stream) {
    static int grid_blocks = 0;
    if (!grid_blocks) {
        int dev = 0, cus = 0, per_cu = 0;
        hipGetDevice(&dev); hipDeviceGetAttribute(&cus, hipDeviceAttributeMultiprocessorCount, dev);
        hipFuncSetAttribute((const void*)fwd_megakernel, hipFuncAttributeMaxDynamicSharedMemorySize, LDS_BYTES);
        hipOccupancyMaxActiveBlocksPerMultiprocessor(&per_cu, (const void*)fwd_megakernel, 512, LDS_BYTES);
        if (per_cu < 1) { fprintf(stderr, "kernel_launch: occupancy query says %d blocks per CU\n", per_cu); per_cu = 1; }
        if (per_cu > 1) per_cu = 1;
        grid_blocks = cus * per_cu;
        if (ws_size < WS_END) fprintf(stderr, "kernel_launch: workspace too small (%zu < %zu)\n", ws_size, (size_t)WS_END);
    }
#ifdef DIAG_MEMSET
    hipMemsetAsync(d_ws, 0xAA, WS_END, stream);
#endif
    (void)hipMemsetAsync((unsigned char*)d_ws + 4096, 0, XCD_BAR_WORDS * 4, stream);
    Params p{};
    for (int i = 0; i < 26; ++i) p.in[i] = (const float*)d_in[i];
    p.out = (float*)d_out; p.ws = (unsigned char*)d_ws;
#if MK_SPLIT
    for (int ph = 0; ph < NPH; ++ph) { p.ph_lo = ph; p.ph_hi = ph + 1; void* args[] = {&p};
        hipError_t e = hipLaunchCooperativeKernel((const void*)fwd_megakernel, dim3(grid_blocks), dim3(512), args, LDS_BYTES, stream);
        if (e != hipSuccess) fprintf(stderr, "launch %d failed: %s\n", ph, hipGetErrorString(e)); }
#else
    p.ph_lo = 0; p.ph_hi = NPH; void* args[] = {&p};
    hipError_t e = hipLaunchCooperativeKernel((const void*)fwd_megakernel, dim3(grid_blocks), dim3(512), args, LDS_BYTES, stream);
    if (e != hipSuccess) fprintf(stderr, "cooperative launch failed: %s (grid %d)\n", hipGetErrorString(e), grid_blocks);
#endif
}
```

```cpp
#include <hip/hip_runtime.h>
#include <hip/hip_cooperative_groups.h>
#include <cstdio>
namespace cg = cooperative_groups;

#define LAS __attribute__((address_space(3)))
typedef unsigned short bf16_t;
typedef short bf16x8 __attribute__((ext_vector_type(8)));
typedef float f32x4 __attribute__((ext_vector_type(4)));
typedef float f32x2 __attribute__((ext_vector_type(2)));
typedef unsigned u32x4 __attribute__((ext_vector_type(4)));
typedef unsigned u32x2 __attribute__((ext_vector_type(2)));

constexpr int MP = 16384, MS = 512, M = MP + MS, D = 1024, FF = 2816, NIN = 6400, WIN_LD = 6160, ZLD = 3072;
constexpr float EPS = 1e-6f;
constexpr int NPH = 12;
constexpr size_t MiB = (size_t)1 << 20;
constexpr size_t OFF_WFFN = 1 * MiB;
constexpr size_t SZ_W1T = (size_t)5632 * 1024 * 2;
constexpr size_t OFF_AT = OFF_WFFN;
constexpr size_t OFF_DECL = OFF_AT + (size_t)1024 * 4096 * 2;
constexpr size_t OFF_GKLR = OFF_DECL + (size_t)1024 * 128 * 4;
constexpr size_t OFF_OSS = OFF_GKLR + (size_t)M * 16 * 4;
static_assert(OFF_OSS + (size_t)M * 64 * 4 <= OFF_WFFN + (size_t)3 * 1024 * 2816 * 2, "overlay fits");
constexpr size_t OFF_WIN = 18 * MiB;
constexpr size_t OFF_WPT = OFF_WIN + (size_t)NIN * 1024 * 2;
constexpr size_t OFF_WOUT = OFF_WPT + (size_t)1024 * 256 * 2;
constexpr size_t OFF_WPG = OFF_WOUT + (size_t)1024 * 1024 * 2;
constexpr size_t OFF_WPP = OFF_WPG + (size_t)1024 * 1024 * 2;
static_assert(OFF_WPP + (size_t)1024 * 256 * 2 <= 36 * MiB, "w rest");
constexpr size_t OFF_HB = 36 * MiB;
constexpr size_t OFF_BIG = 69 * MiB;
constexpr size_t OFF_SGA = 168 * MiB;
constexpr size_t OFF_P = 201 * MiB;
constexpr size_t OFF_PB = 234 * MiB;
constexpr size_t OFF_SSA = 243 * MiB;
constexpr size_t OFF_SSB = 245 * MiB;
constexpr size_t WS_END = 247 * MiB;
constexpr size_t OUT_NPP = (size_t)M * 1024;
constexpr size_t OUT_NGP = OUT_NPP + (size_t)8 * 15 * 1024;
constexpr size_t OUT_NPS = OUT_NGP + (size_t)8 * 4 * 128 * 256;
constexpr size_t OUT_NGS = OUT_NPS + (size_t)128 * 15 * 1024;
constexpr int LDS_BYTES = 147456;

typedef __bf16 bf16v2_t __attribute__((ext_vector_type(2)));
__device__ __forceinline__ unsigned cvt_pk_bf16(float lo, float hi) { bf16v2_t v; v[0] = (__bf16)lo; v[1] = (__bf16)hi; return __builtin_bit_cast(unsigned, v); }
__device__ __forceinline__ float bf_lo(unsigned w) { return __uint_as_float(w << 16); }
__device__ __forceinline__ float bf_hi(unsigned w) { return __uint_as_float(w & 0xffff0000u); }
__device__ __forceinline__ float bf1(bf16_t b) { return __uint_as_float(((unsigned)b) << 16); }
__device__ __forceinline__ bf16_t f2bf(float f) { return (bf16_t)(cvt_pk_bf16(f, 0.f) & 0xffffu); }
__device__ __forceinline__ u32x2 pack4(f32x4 v) { u32x2 w; w.x = cvt_pk_bf16(v[0], v[1]); w.y = cvt_pk_bf16(v[2], v[3]); return w; }
__device__ __forceinline__ u32x4 pack8(f32x4 a, f32x4 b) { u32x4 w; w.x = cvt_pk_bf16(a[0], a[1]); w.y = cvt_pk_bf16(a[2], a[3]); w.z = cvt_pk_bf16(b[0], b[1]); w.w = cvt_pk_bf16(b[2], b[3]); return w; }
__device__ __forceinline__ f32x4 unpack_lo(u32x4 w) { return (f32x4){bf_lo(w.x), bf_hi(w.x), bf_lo(w.y), bf_hi(w.y)}; }
__device__ __forceinline__ f32x4 unpack_hi(u32x4 w) { return (f32x4){bf_lo(w.z), bf_hi(w.z), bf_lo(w.w), bf_hi(w.w)}; }
__device__ __forceinline__ f32x4 unpack4(u32x2 w) { return (f32x4){bf_lo(w.x), bf_hi(w.x), bf_lo(w.y), bf_hi(w.y)}; }
__device__ __forceinline__ float sigmoidf_(float x) { return __builtin_amdgcn_rcpf(1.0f + __builtin_amdgcn_exp2f(-1.4426950409f * x)); }
__device__ __forceinline__ f32x4 sigmoid4(f32x4 x) { return (f32x4){sigmoidf_(x[0]), sigmoidf_(x[1]), sigmoidf_(x[2]), sigmoidf_(x[3])}; }
__device__ __forceinline__ float sum16(const float* p) { const f32x4* q = (const f32x4*)p; const f32x4 a = q[0], b = q[1], c = q[2], d = q[3];
    return ((a[0] + a[1]) + (a[2] + a[3])) + ((b[0] + b[1]) + (b[2] + b[3])) + ((c[0] + c[1]) + (c[2] + c[3])) + ((d[0] + d[1]) + (d[2] + d[3])); }
__device__ __forceinline__ float rowscale(const float* ss, int row, float invn) { return 1.0f / sqrtf(sum16(ss + (size_t)row * 16) * invn + EPS); }
__device__ __forceinline__ float wave_sum(float v) {
#pragma unroll
    for (int o = 1; o < 64; o <<= 1) v += __shfl_xor(v, o);
    return v; }

namespace pg8 {
constexpr int BM = 256, BK = 64, HALF = 128, HTB = HALF * BK * 2, NXCD = 8, WGM = 4;
__device__ __forceinline__ int lds_byte(int r, int c) { const int st = (r >> 4) * 2 + (c >> 5), rr = r & 15, cc = c & 31, ob = rr * 64 + cc * 2; return st * 1024 + (ob ^ (((ob >> 9) & 1) << 5)); }
__device__ __forceinline__ void stage_rc(int b, int& R, int& C) { const int st = b / 1024, sb = b % 1024, swz = sb ^ (((sb >> 9) & 1) << 5); R = (st >> 1) * 16 + swz / 64; C = (st & 1) * 32 + (swz % 64) / 2; }
struct Unit { int pm, pn; };
struct Gemm { const bf16_t* A; const bf16_t* Bt; int K, lda, ldb, a_pn_off; };
struct StaticOrder {
    int nM, nN, nwg, G, c;
    __device__ void init(int M_, int N_, int G_, int c_) { nM = M_ / BM; nN = N_ / BM; nwg = nM * nN; G = G_; c = c_; }
    __device__ bool next(int i, Unit& u) const {
        const long L = (long)i * G + c; if (L >= nwg) return false;
        int wgid = (int)L; { const int q = nwg / NXCD, r = nwg % NXCD, xcd = wgid % NXCD, off = wgid / NXCD; wgid = (xcd < r ? xcd * (q + 1) : r * (q + 1) + (xcd - r) * q) + off; }
        const int nig = WGM * nN, gid = wgid / nig, fm = gid * WGM, gsz = (nM - fm) < WGM ? (nM - fm) : WGM;
        u.pm = fm + ((wgid % nig) % gsz); u.pn = (wgid % nig) / gsz; return true;
    }
};
struct NoPre { __device__ __forceinline__ void operator()() const {} };
template <class Epi, class Pre = NoPre>
__device__ __forceinline__ void gemm_phase(LAS unsigned char* lds, const Gemm g, const StaticOrder& S, const Epi& E, const Pre& pre = Pre()) {
    const int tid = threadIdx.x, wid = __builtin_amdgcn_readfirstlane(tid >> 6), lane = tid & 63, wr = wid >> 2, wc = wid & 3, fr = lane & 15, fq = lane >> 4;
    int K_ = g.K; asm volatile("" : "+s"(K_));
    const int K = K_, nt = K / BK;
    unsigned voffA[2], voffB[2];
#pragma unroll
    for (int i = 0; i < 2; ++i) { int R, C; stage_rc(tid * 16 + i * 8192, R, C); voffA[i] = (unsigned)(R * g.lda + C) * 2u; voffB[i] = (unsigned)(R * g.ldb + C) * 2u; }
    const size_t kstep = (size_t)(BK * 2);
    const size_t hsA = (size_t)HALF * g.lda * 2, hsB = (size_t)HALF * g.ldb * 2, tsA = 2 * hsA, tsB = 2 * hsB;
    const unsigned ldsw = (unsigned)wid * 1024u;
    const int aoff = lds_byte(wr * 64 + fr, fq * 8), boff = lds_byte(wc * 32 + fr, fq * 8);
#define PG8_SA(b, h) (((b) * 2 + (h)) * HTB)
#define PG8_SB(b, h) ((4 + (b) * 2 + (h)) * HTB)
#define PG8_STAGE(bufoff, gbase, voff) do { _Pragma("unroll") for (int _i = 0; _i < 2; ++_i) \
        __builtin_amdgcn_global_load_lds((const unsigned*)((const char*)(gbase) + (voff)[_i]), (LAS unsigned*)(lds + (bufoff) + ldsw + _i * 8192), 16, 0, 0); } while (0)
#define PG8_LDA(dst, b, h) do { _Pragma("unroll") for (int m = 0; m < 4; ++m) _Pragma("unroll") for (int k = 0; k < 2; ++k) dst[m][k] = *(const LAS bf16x8*)(lds + PG8_SA(b, h) + aoff + m * 2048 + k * 1024); } while (0)
#define PG8_LDB(dst, b, h) do { _Pragma("unroll") for (int n = 0; n < 2; ++n) _Pragma("unroll") for (int k = 0; k < 2; ++k) dst[n][k] = *(const LAS bf16x8*)(lds + PG8_SB(b, h) + boff + n * 2048 + k * 1024); } while (0)
#define PG8_MMA(ai, bj, At, Bt) do { __builtin_amdgcn_s_setprio(1); _Pragma("unroll") for (int m = 0; m < 4; ++m) _Pragma("unroll") for (int n = 0; n < 2; ++n) _Pragma("unroll") for (int k = 0; k < 2; ++k) \
        acc[ai][bj][m][n] = __builtin_amdgcn_mfma_f32_16x16x32_bf16(Bt[n][k], At[m][k], acc[ai][bj][m][n], 0, 0, 0); __builtin_amdgcn_s_setprio(0); } while (0)
#define PG8_WAIT_V(n) asm volatile("s_waitcnt vmcnt(" #n ")" ::: "memory")
#define PG8_WAIT_L(n) asm volatile("s_waitcnt lgkmcnt(" #n ")" ::: "memory")
#define PG8_BAR __builtin_amdgcn_s_barrier()
#define PG8_SCHED __builtin_amdgcn_sched_barrier(0)
    Unit cur, nxt; int ui = 0;
    if (!S.next(0, cur)) return;
    f32x4 acc[2][2][4][2];
#pragma unroll
    for (int a = 0; a < 2; ++a)
#pragma unroll
        for (int b = 0; b < 2; ++b)
#pragma unroll
            for (int m = 0; m < 4; ++m)
#pragma unroll
                for (int n = 0; n < 2; ++n) acc[a][b][m][n] = (f32x4){0.f, 0.f, 0.f, 0.f};
    bf16x8 At[4][2], B0[2][2], B1[2][2];
    const char* cA = (const char*)g.A + (size_t)cur.pm * tsA + (size_t)cur.pn * g.a_pn_off; const char* cB = (const char*)g.Bt + (size_t)cur.pn * tsB;
    PG8_STAGE(PG8_SB(0, 0), cB, voffB); PG8_STAGE(PG8_SA(0, 0), cA, voffA); PG8_STAGE(PG8_SB(0, 1), cB + hsB, voffB); PG8_STAGE(PG8_SA(0, 1), cA + hsA, voffA);
    pre();
    if (wr == 1) PG8_BAR;
    PG8_WAIT_V(4); PG8_BAR;
    PG8_STAGE(PG8_SB(1, 0), cB + kstep, voffB); PG8_STAGE(PG8_SA(1, 0), cA + kstep, voffA); PG8_STAGE(PG8_SB(1, 1), cB + hsB + kstep, voffB);
    PG8_WAIT_V(6); PG8_BAR;
    for (;;) {
        const bool has_next = S.next(ui + 1, nxt);
        const char* nA = has_next ? (const char*)g.A + (size_t)nxt.pm * tsA + (size_t)nxt.pn * g.a_pn_off : cA; const char* nB = has_next ? (const char*)g.Bt + (size_t)nxt.pn * tsB : cB;
#pragma unroll 1
        for (int t = 0; t < nt; t += 2) {
            const bool last = (t == nt - 2);
            const char* a1 = cA + (size_t)(t + 1) * kstep;
            const char* a2 = last ? nA : cA + (size_t)(t + 2) * kstep; const char* b2 = last ? nB : cB + (size_t)(t + 2) * kstep;
            const char* a3 = a2 + kstep; const char* b3 = b2 + kstep;
            PG8_LDB(B0, 0, 0); PG8_SCHED; PG8_LDA(At, 0, 0); PG8_STAGE(PG8_SA(1, 1), a1 + hsA, voffA);
            PG8_WAIT_L(8); PG8_BAR; PG8_WAIT_L(0); PG8_MMA(0, 0, At, B0); PG8_BAR; PG8_SCHED;
            PG8_LDB(B1, 0, 1); PG8_STAGE(PG8_SB(0, 0), b2, voffB);
            PG8_BAR; PG8_WAIT_L(0); PG8_MMA(0, 1, At, B1); PG8_BAR;
            PG8_LDA(At, 0, 1); PG8_STAGE(PG8_SA(0, 0), a2, voffA);
            PG8_BAR; PG8_WAIT_L(0); PG8_MMA(1, 0, At, B0); PG8_BAR; PG8_SCHED;
            PG8_STAGE(PG8_SB(0, 1), b2 + hsB, voffB);
            PG8_WAIT_V(6); PG8_BAR; PG8_MMA(1, 1, At, B1); PG8_BAR;
            PG8_LDB(B0, 1, 0); PG8_SCHED; PG8_LDA(At, 1, 0); PG8_STAGE(PG8_SA(0, 1), a2 + hsA, voffA);
            PG8_WAIT_L(8); PG8_BAR; PG8_WAIT_L(0); PG8_MMA(0, 0, At, B0); PG8_BAR; PG8_SCHED;
            PG8_LDB(B1, 1, 1); PG8_STAGE(PG8_SB(1, 0), b3, voffB);
            PG8_BAR; PG8_WAIT_L(0); PG8_MMA(0, 1, At, B1); PG8_BAR;
            PG8_LDA(At, 1, 1); PG8_STAGE(PG8_SA(1, 0), a3, voffA);
            PG8_BAR; PG8_WAIT_L(0); PG8_MMA(1, 0, At, B0); PG8_BAR; PG8_SCHED;
            PG8_STAGE(PG8_SB(1, 1), b3 + hsB, voffB);
            PG8_WAIT_V(6); PG8_BAR; PG8_MMA(1, 1, At, B1); PG8_BAR;
        }
        E(acc, cur, ui, wr, wc, fr, fq);
        if (!has_next) break;
#pragma unroll
        for (int a = 0; a < 2; ++a)
#pragma unroll
            for (int b = 0; b < 2; ++b)
#pragma unroll
                for (int m = 0; m < 4; ++m)
#pragma unroll
                    for (int n = 0; n < 2; ++n) acc[a][b][m][n] = (f32x4){0.f, 0.f, 0.f, 0.f};
        cur = nxt; cA = nA; cB = nB; ++ui;
    }
    PG8_WAIT_V(0);
    if (wr == 0) PG8_BAR;
    PG8_BAR;
#undef PG8_SA
#undef PG8_SB
#undef PG8_STAGE
#undef PG8_LDA
#undef PG8_LDB
#undef PG8_MMA
#undef PG8_WAIT_V
#undef PG8_WAIT_L
#undef PG8_BAR
#undef PG8_SCHED
}
}
using pg8::Unit;
typedef const f32x4 (&AccRef)[2][2][4][2];
constexpr int RS_OFF = 131072;
__device__ __forceinline__ void fill_rs(LAS unsigned char* lds, const pg8::StaticOrder& S, const float* ss) {
    LAS float* tab = (LAS float*)(lds + RS_OFF); Unit u; const int wave = threadIdx.x >> 6, lane = threadIdx.x & 63;
    if (S.next(wave, u)) { float v[4];
#pragma unroll
        for (int k = 0; k < 4; ++k) v[k] = sum16(ss + (size_t)(u.pm * 256 + lane + 64 * k) * 16);
#pragma unroll
        for (int k = 0; k < 4; ++k) tab[wave * 256 + lane + 64 * k] = 1.0f / sqrtf(v[k] * (1.0f / 1024.0f) + EPS); }
    __syncthreads();
}
__device__ __forceinline__ void fill_rso(LAS unsigned char* lds, const pg8::StaticOrder& S, const float* oss) {
    LAS float* tab = (LAS float*)(lds + RS_OFF); Unit u; const int wave = threadIdx.x >> 6, lane = threadIdx.x & 63;
    if (S.next(wave, u)) { float v[4];
#pragma unroll
        for (int k = 0; k < 4; ++k) v[k] = sum16(oss + (size_t)(u.pm * 256 + lane + 64 * k) * 64 + u.pn * 16);
#pragma unroll
        for (int k = 0; k < 4; ++k) tab[wave * 256 + lane + 64 * k] = 1.0f / sqrtf(v[k] * (1.0f / 256.0f) + EPS); }
    __syncthreads();
}
struct PreRs { LAS unsigned char* lds; const pg8::StaticOrder* S; const float* ss; __device__ __forceinline__ void operator()() const { fill_rs(lds, *S, ss); } };
struct PreRso { LAS unsigned char* lds; const pg8::StaticOrder* S; const float* oss; __device__ __forceinline__ void operator()() const { fill_rso(lds, *S, oss); } };
struct EpiSwiglu { bf16_t* act; const LAS float* rs_tab;
    __device__ __forceinline__ void operator()(AccRef acc, const Unit& u, int ui, int wr, int wc, int fr, int fq) const {
        const int rl0 = wr * 64 + fr; const LAS float* tab = rs_tab + ui * 256 + rl0;
        bf16_t* base = act + (size_t)(u.pm * 256 + rl0) * FF + u.pn * 128 + wc * 32 + fq * 8;
#pragma unroll
        for (int ai = 0; ai < 2; ++ai)
#pragma unroll
            for (int m = 0; m < 4; ++m) { const int rl = ai * 128 + m * 16; const float rs = tab[rl]; f32x4 o[2];
#pragma unroll
                for (int bj = 0; bj < 2; ++bj) { const f32x4 gt = acc[ai][bj][m][0] * rs, up = acc[ai][bj][m][1] * rs; o[bj] = gt * sigmoid4(gt) * up; }
                *(u32x4*)(base + (size_t)rl * FF) = pack8(o[0], o[1]); }
    } };
struct EpiResid { bf16_t* hb; float* ssw; float scale;
    __device__ __forceinline__ void operator()(AccRef acc, const Unit& u, int ui, int wr, int wc, int fr, int fq) const {
        const int row0 = u.pm * 256 + wr * 64 + fr, col0 = u.pn * 256 + wc * 32 + fq * 8;
        bf16_t* hbase = hb + (size_t)row0 * 1024 + col0; float* sbase = ssw + (size_t)row0 * 16 + u.pn * 4 + wc;
        u32x4 r[8][2];
#pragma unroll
        for (int g = 0; g < 8; ++g) { const int rl = (g >> 2) * 128 + (g & 3) * 16;
#pragma unroll
            for (int bj = 0; bj < 2; ++bj) r[g][bj] = *(const u32x4*)(hbase + (size_t)rl * 1024 + bj * 128); }
#pragma unroll
        for (int g = 0; g < 8; ++g) { const int ai = g >> 2, m = g & 3, rl = ai * 128 + m * 16; float sq = 0.f;
#pragma unroll
            for (int bj = 0; bj < 2; ++bj) { const f32x4 v0 = unpack_lo(r[g][bj]) + acc[ai][bj][m][0] * scale, v1 = unpack_hi(r[g][bj]) + acc[ai][bj][m][1] * scale;
                *(u32x4*)(hbase + (size_t)rl * 1024 + bj * 128) = pack8(v0, v1);
                sq += ((v0[0] * v0[0] + v0[1] * v0[1]) + (v0[2] * v0[2] + v0[3] * v0[3])) + ((v1[0] * v1[0] + v1[1] * v1[1]) + (v1[2] * v1[2] + v1[3] * v1[3])); }
            sq += __shfl_xor(sq, 16); sq += __shfl_xor(sq, 32);
            if (fq == 0) sbase[(size_t)rl * 16] = sq; }
    } };
struct EpiZ { bf16_t* zA; bf16_t* sga; bf16_t* P; float* gklr; const LAS float* rs_tab; const float* gnorm;
    __device__ __forceinline__ void operator()(AccRef acc, const Unit& u, int ui, int wr, int wc, int fr, int fq) const {
        const int rl0 = wr * 64 + fr, row0 = u.pm * 256 + rl0; const int pn = u.pn; const LAS float* tab = rs_tab + ui * 256 + rl0;
        if (pn < 12) { bf16_t* base = zA + (size_t)row0 * ZLD + pn * 256 + wc * 32 + fq * 8;
#pragma unroll
            for (int ai = 0; ai < 2; ++ai)
#pragma unroll
                for (int m = 0; m < 4; ++m) { const int rl = ai * 128 + m * 16; const float rs = tab[rl];
#pragma unroll
                    for (int bj = 0; bj < 2; ++bj) *(u32x4*)(base + (size_t)rl * ZLD + bj * 128) = pack8(acc[ai][bj][m][0] * rs, acc[ai][bj][m][1] * rs); }
        } else if (pn < 16) { bf16_t* base = sga + (size_t)row0 * 1024 + (pn - 12) * 256 + wc * 32 + fq * 8;
#pragma unroll
            for (int ai = 0; ai < 2; ++ai)
#pragma unroll
                for (int m = 0; m < 4; ++m) { const int rl = ai * 128 + m * 16; const float rs = tab[rl];
#pragma unroll
                    for (int bj = 0; bj < 2; ++bj) *(u32x4*)(base + (size_t)rl * 1024 + bj * 128) = pack8(sigmoid4(acc[ai][bj][m][0] * rs), sigmoid4(acc[ai][bj][m][1] * rs)); }
        } else if (pn < 24) { const int c0 = (pn - 16) * 128 + wc * 32 + fq * 8; bf16_t* base = P + (size_t)row0 * 1024 + c0;
            const f32x4 gn0 = *(const f32x4*)(gnorm + (c0 & 255)), gn1 = *(const f32x4*)(gnorm + ((c0 + 4) & 255));
#pragma unroll
            for (int ai = 0; ai < 2; ++ai)
#pragma unroll
                for (int m = 0; m < 4; ++m) { const int rl = ai * 128 + m * 16; const float rs = tab[rl]; f32x4 o[2];
#pragma unroll
                    for (int bj = 0; bj < 2; ++bj) { const f32x4 gv = acc[ai][bj][m][0] * rs, gb = acc[ai][bj][m][1] * rs; o[bj] = sigmoid4(gb) * gv * sigmoid4(gv) * (bj ? gn1 : gn0); }
                    *(u32x4*)(base + (size_t)rl * 1024) = pack8(o[0], o[1]); }
        } else if (wc == 0 && fq < 2) {
#pragma unroll
            for (int ai = 0; ai < 2; ++ai)
#pragma unroll
                for (int m = 0; m < 4; ++m) { const int rl = ai * 128 + m * 16; const float rs = tab[rl];
                    *(f32x4*)(gklr + (size_t)(row0 + rl) * 16 + fq * 8) = acc[ai][0][m][0] * rs; *(f32x4*)(gklr + (size_t)(row0 + rl) * 16 + fq * 8 + 4) = acc[ai][0][m][1] * rs; }
        }
    } };
struct EpiMix { bf16_t* sga; const bf16_t* P; const bf16_t* o; const LAS float* rso_tab;
    __device__ __forceinline__ void operator()(AccRef acc, const Unit& u, int ui, int wr, int wc, int fr, int fq) const {
        const int rl0 = wr * 64 + fr, row0 = u.pm * 256 + rl0; const int colb = u.pn * 256 + wc * 32 + fq * 8; const LAS float* tab = rso_tab + ui * 256 + rl0;
        bf16_t* sb = sga + (size_t)row0 * 1024 + colb; const bf16_t* pb_ = P + (size_t)row0 * 1024 + colb; const bf16_t* ob = o + (size_t)row0 * ZLD + colb;
        u32x4 ro[3][2], rsg[3][2], rp[3][2];
#define MIX_LD(slot, g_) do { const int rl_ = ((g_) >> 2) * 128 + ((g_) & 3) * 16; _Pragma("unroll") for (int bj = 0; bj < 2; ++bj) { \
            ro[slot][bj] = *(const u32x4*)(ob + (size_t)rl_ * ZLD + bj * 128); rsg[slot][bj] = *(const u32x4*)(sb + (size_t)rl_ * 1024 + bj * 128); rp[slot][bj] = *(const u32x4*)(pb_ + (size_t)rl_ * 1024 + bj * 128); } } while (0)
        MIX_LD(0, 0); MIX_LD(1, 1); MIX_LD(2, 2);
#pragma unroll
        for (int g = 0; g < 8; ++g) { const int ai = g >> 2, m = g & 3, rl = ai * 128 + m * 16; const float rso = tab[rl]; u32x4 res[2];
#pragma unroll
            for (int bj = 0; bj < 2; ++bj) res[bj] = pack8(unpack_lo(rsg[g % 3][bj]) * acc[ai][bj][m][0] + unpack_lo(rp[g % 3][bj]) * (unpack_lo(ro[g % 3][bj]) * rso),
                                                           unpack_hi(rsg[g % 3][bj]) * acc[ai][bj][m][1] + unpack_hi(rp[g % 3][bj]) * (unpack_hi(ro[g % 3][bj]) * rso));
            if (g + 3 < 8) MIX_LD(g % 3, g + 3);
#pragma unroll
            for (int bj = 0; bj < 2; ++bj) *(u32x4*)(sb + (size_t)rl * 1024 + bj * 128) = res[bj];
        }
#undef MIX_LD
    } };
struct EpiBf16 { bf16_t* out;
    __device__ __forceinline__ void operator()(AccRef acc, const Unit& u, int ui, int wr, int wc, int fr, int fq) const {
        bf16_t* base = out + (size_t)(u.pm * 256 + wr * 64 + fr) * 1024 + u.pn * 256 + wc * 32 + fq * 8;
#pragma unroll
        for (int ai = 0; ai < 2; ++ai)
#pragma unroll
            for (int m = 0; m < 4; ++m)
#pragma unroll
                for (int bj = 0; bj < 2; ++bj) *(u32x4*)(base + (size_t)(ai * 128 + m * 16) * 1024 + bj * 128) = pack8(acc[ai][bj][m][0], acc[ai][bj][m][1]);
    } };
struct EpiPle { bf16_t* h; const bf16_t* hb; const bf16_t* pp; const LAS float* rs_tab; float* ssw;
    __device__ __forceinline__ void operator()(AccRef acc, const Unit& u, int ui, int wr, int wc, int fr, int fq) const {
        const int rl0 = wr * 64 + fr, row0 = u.pm * 256 + rl0, col0 = u.pn * 256 + wc * 32 + fq * 8; const LAS float* tab = rs_tab + ui * 256 + rl0;
        bf16_t* obase = h + (size_t)row0 * 1024 + col0; const bf16_t* hbase = hb + (size_t)row0 * 1024 + col0; const bf16_t* pbase = pp + (size_t)row0 * 1024 + col0; float* sbase = ssw + (size_t)row0 * 16 + u.pn * 4 + wc;
        u32x4 rh[4][2], rp[4][2];
#define PLE_LD(slot, g_) do { const int rl_ = ((g_) >> 2) * 128 + ((g_) & 3) * 16; _Pragma("unroll") for (int bj = 0; bj < 2; ++bj) { \
            rh[slot][bj] = *(const u32x4*)(hbase + (size_t)rl_ * 1024 + bj * 128); rp[slot][bj] = *(const u32x4*)(pbase + (size_t)rl_ * 1024 + bj * 128); } } while (0)
        PLE_LD(0, 0); PLE_LD(1, 1); PLE_LD(2, 2); PLE_LD(3, 3);
#pragma unroll
        for (int g = 0; g < 8; ++g) { const int ai = g >> 2, m = g & 3, rl = ai * 128 + m * 16; const float rs = tab[rl]; float sq = 0.f; f32x4 res[2][2];
#pragma unroll
            for (int bj = 0; bj < 2; ++bj) { const f32x4 v0 = unpack_lo(rh[g & 3][bj]) + sigmoid4(acc[ai][bj][m][0] * rs) * unpack_lo(rp[g & 3][bj]), v1 = unpack_hi(rh[g & 3][bj]) + sigmoid4(acc[ai][bj][m][1] * rs) * unpack_hi(rp[g & 3][bj]);
                res[bj][0] = v0; res[bj][1] = v1; sq += ((v0[0] * v0[0] + v0[1] * v0[1]) + (v0[2] * v0[2] + v0[3] * v0[3])) + ((v1[0] * v1[0] + v1[1] * v1[1]) + (v1[2] * v1[2] + v1[3] * v1[3])); }
            if (g + 4 < 8) PLE_LD(g & 3, g + 4);
#pragma unroll
            for (int bj = 0; bj < 2; ++bj) *(u32x4*)(obase + (size_t)rl * 1024 + bj * 128) = pack8(res[bj][0], res[bj][1]);
            sq += __shfl_xor(sq, 16); sq += __shfl_xor(sq, 32);
            if (fq == 0) sbase[(size_t)rl * 16] = sq; }
#undef PLE_LD
    } };

struct Params { const float* in[26]; float* out; unsigned char* ws; int ph_lo, ph_hi; };

template <int MODE>
__device__ __forceinline__ void tr_item(const float* src0, const float* src1, int ldsrc, int K, bf16_t* dst, const float* gain, LAS float* scr, int item, int nblk, int lane, const float* cs = nullptr) {
    const int kb = item / nblk, nb = item % nblk, k0 = 64 * kb, n0 = 32 * nb;
    const int r8 = lane >> 3, c4 = (lane & 7) * 4; const float* sp; f32x4 sc = (f32x4){1.f, 1.f, 1.f, 1.f};
    const int lc = 8 * ((c4 >> 2) & 3) + 4 * (c4 >> 4);
    const int gq = (n0 & 255) >> 5, fi = (n0 >> 8) * 128 + (gq & 3) * 32 + ((c4 >> 2) & 3) * 8 + (gq >> 2) * 4;
    if (MODE == 0) { sp = src0 + n0 + lc; if (cs) sc = *(const f32x4*)(cs + n0 + lc); }
    else if (MODE == 1) { sp = ((c4 >> 4) ? src1 : src0) + fi; }
    else { const int n = n0 + lc;
           if (n0 < 3072) { sp = src0 + n; if (n0 >= 1024 && n0 < 1536) sc = sc * 0.08838834764831845f; }
           else if (n0 < 4096) sp = src0 + 4112 + (n - 3072);
           else if (n0 < 6144) sp = src0 + ((c4 >> 4) ? 5136 : 3088) + (fi - 2048);
           else if (n0 == 6144 && lc < 16) sp = src0 + 3072 + lc;
           else sp = nullptr; }
    f32x4 v[8];
#pragma unroll
    for (int i = 0; i < 8; ++i) { const int kk = 8 * i + r8; v[i] = sp ? *(const f32x4*)(sp + (size_t)(k0 + kk) * ldsrc) : (f32x4){0.f, 0.f, 0.f, 0.f}; }
#pragma unroll
    for (int i = 0; i < 8; ++i) { const int kk = 8 * i + r8; f32x4 t = v[i] * sc; if (gain) t = t * gain[k0 + kk];
        scr[kk * 33 + c4] = t[0]; scr[kk * 33 + c4 + 1] = t[1]; scr[kk * 33 + c4 + 2] = t[2]; scr[kk * 33 + c4 + 3] = t[3]; }
    asm volatile("s_waitcnt lgkmcnt(0)" ::: "memory");
    const int c = lane & 7;
#pragma unroll
    for (int j = 0; j < 4; ++j) { const int nn = (lane >> 3) + 8 * j; const LAS float* s_ = scr + (8 * c) * 33 + nn;
        u32x4 o; o.x = cvt_pk_bf16(s_[0 * 33], s_[1 * 33]); o.y = cvt_pk_bf16(s_[2 * 33], s_[3 * 33]); o.z = cvt_pk_bf16(s_[4 * 33], s_[5 * 33]); o.w = cvt_pk_bf16(s_[6 * 33], s_[7 * 33]);
        *(u32x4*)(dst + (size_t)(n0 + nn) * K + k0 + 8 * c) = o; }
    asm volatile("s_waitcnt lgkmcnt(0)" ::: "memory");
}
__device__ __forceinline__ void conv_ffn(const Params& p, int base, bf16_t* w1t, LAS float* scr, int gw, int NGW, int lane, int part = 0) {
    bf16_t* w2t = w1t + SZ_W1T / 2;
    constexpr int I1 = 16 * 176, I2 = 44 * 32;
    const int lo_ = (part == 2) ? I1 : 0, hi_ = (part == 1) ? I1 : I1 + I2;
    for (int it = lo_ + gw; it < hi_; it += NGW) {
        if (it < I1) tr_item<1>(p.in[base + 1], p.in[base + 2], FF, 1024, w1t, p.in[base], scr, it, 176, lane);
        else tr_item<0>(p.in[base + 3], nullptr, 1024, FF, w2t, nullptr, scr, it - I1, 32, lane);
    }
}
constexpr size_t Y_FFN2_OFF = (size_t)33 * MiB;
__device__ __forceinline__ void conv_rest(const Params& p, LAS unsigned char* lds, int gw, int NGW) {
    const int tid = threadIdx.x, lane = tid & 63, wave = tid >> 6; LAS float* scr = (LAS float*)(lds + wave * 16384); unsigned char* ws = p.ws;
    constexpr int I_IN = 16 * 200, I_POOL = 4 * 4 * 8, I_OUT = 16 * 32, I_PG = 16 * 32, I_PP = 4 * 32;
    for (int it = gw; it < I_IN + I_POOL + I_OUT + I_PG + I_PP; it += NGW) {
        int r = it;
        if (r < I_IN) { tr_item<2>(p.in[11], nullptr, WIN_LD, 1024, (bf16_t*)(ws + OFF_WIN), p.in[10], scr, r, 200, lane); continue; } r -= I_IN;
        if (r < I_POOL) { const int g = r >> 5; tr_item<0>(p.in[15] + (size_t)g * 65536, nullptr, 256, 256, (bf16_t*)(ws + OFF_WPT) + (size_t)g * 65536, nullptr, scr, r & 31, 8, lane, p.in[16] + g * 256); continue; } r -= I_POOL;
        if (r < I_OUT) { tr_item<0>(p.in[17], nullptr, 1024, 1024, (bf16_t*)(ws + OFF_WOUT), nullptr, scr, r, 32, lane); continue; } r -= I_OUT;
        if (r < I_PG) { tr_item<0>(p.in[23], nullptr, 1024, 1024, (bf16_t*)(ws + OFF_WPG), p.in[22], scr, r, 32, lane); continue; } r -= I_PG;
        tr_item<0>(p.in[24], nullptr, 1024, 256, (bf16_t*)(ws + OFF_WPP), nullptr, scr, r, 32, lane);
    }
}
__device__ __forceinline__ void phase_prep(const Params& p, LAS unsigned char* lds) {
    const int tid = threadIdx.x, lane = tid & 63, wave = tid >> 6; const int gw = blockIdx.x * 8 + wave, NGW = gridDim.x * 8;
    LAS float* scr = (LAS float*)(lds + wave * 16384);
    unsigned char* ws = p.ws;
    conv_ffn(p, 6, (bf16_t*)(ws + OFF_WFFN), scr, gw, NGW, lane);
    bf16_t* xb = (bf16_t*)(ws + OFF_HB); float* ssa = (float*)(ws + OFF_SSA); bf16_t* pb = (bf16_t*)(ws + OFF_PB);
    for (int row0 = gw; row0 < M; row0 += 2 * NGW) {
        f32x4 v[2][4], pv[2]; float sx[2];
#pragma unroll
        for (int e = 0; e < 2; ++e) { const int row = row0 + e * NGW; if (row < M) {
            const float* xr = (row < MP) ? p.in[0] + (size_t)row * 1024 : p.in[1] + (size_t)(row - MP) * 1024;
            const float* pr = (row < MP) ? p.in[2] + (size_t)row * 256 : p.in[3] + (size_t)(row - MP) * 256;
#pragma unroll
            for (int j = 0; j < 4; ++j) v[e][j] = *(const f32x4*)(xr + j * 256 + lane * 4);
            pv[e] = *(const f32x4*)(pr + lane * 4); } }
#pragma unroll
        for (int e = 0; e < 2; ++e) { const int row = row0 + e * NGW; if (row < M) { float s_ = 0.f;
#pragma unroll
            for (int j = 0; j < 4; ++j) s_ += (v[e][j][0] * v[e][j][0] + v[e][j][1] * v[e][j][1]) + (v[e][j][2] * v[e][j][2] + v[e][j][3] * v[e][j][3]);
            sx[e] = wave_sum(s_);
#pragma unroll
            for (int j = 0; j < 4; ++j) *(u32x2*)(xb + (size_t)row * 1024 + j * 256 + lane * 4) = pack4(v[e][j]);
            if (lane < 16) ssa[(size_t)row * 16 + lane] = (lane == 0) ? sx[e] : 0.f;
            *(u32x2*)(pb + (size_t)row * 256 + lane * 4) = pack4(pv[e]); } }
    }
}

__device__ __forceinline__ float logsig16(float x) { return (fminf(x, 0.f) - __logf(1.0f + __expf(-fabsf(x)))) * 0.0625f; }
struct PrepPf { f32x4 gk; u32x4 v[4], q[2], k[2]; };
__device__ __forceinline__ void prep_prefetch(const Params& p, int item, PrepPf& pf) {
    const bf16_t* zA = (const bf16_t*)(p.ws + OFF_BIG); const float* gklr = (const float*)(p.ws + OFF_GKLR);
    const int b = item >> 7, n = (item >> 2) & 31, h = item & 3, r0 = b * 2048 + n * 64, tid = threadIdx.x;
    pf.gk = (f32x4){0.f, 0.f, 0.f, 0.f};
    if (tid < 256) pf.gk = *(const f32x4*)(gklr + (size_t)r0 * 16 + tid * 4);
#pragma unroll
    for (int x = 0; x < 4; ++x) { const int q = tid + 512 * x, row = q >> 5, cc = q & 31; pf.v[x] = *(const u32x4*)(zA + (size_t)(r0 + row) * ZLD + 2048 + h * 256 + cc * 8); }
#pragma unroll
    for (int x = 0; x < 2; ++x) { const int q = tid + 512 * x, row = q >> 4, cc = q & 15;
        pf.q[x] = *(const u32x4*)(zA + (size_t)(r0 + row) * ZLD + 1024 + h * 128 + cc * 8); pf.k[x] = *(const u32x4*)(zA + (size_t)(r0 + row) * ZLD + 1536 + h * 128 + cc * 8); }
}
__device__ __forceinline__ void gla_prep_item(const Params& p, LAS unsigned char* lds, int item, PrepPf& pf, int next_item) {
    unsigned char* ws = p.ws; bf16_t* zA = (bf16_t*)(ws + OFF_BIG);
    bf16_t* At = (bf16_t*)(ws + OFF_AT); float* decl = (float*)(ws + OFF_DECL);
    const int b = item >> 7, n = (item >> 2) & 31, h = item & 3, r0 = b * 2048 + n * 64;
    const int tid = threadIdx.x, cch = tid & 127, jq = tid >> 7, lane = tid & 63, wave = tid >> 6, fr = lane & 15, fq = lane >> 4;
    LAS float* gk_l = (LAS float*)lds; LAS float* tot = (LAS float*)(lds + 4096);
    LAS bf16_t* QL = (LAS bf16_t*)(lds + 6144); LAS bf16_t* KL = (LAS bf16_t*)(lds + 23552); LAS bf16_t* VL = (LAS bf16_t*)(lds + 40960);
    if (tid < 256) *(LAS f32x4*)(gk_l + tid * 4) = pf.gk;
#pragma unroll
    for (int x = 0; x < 4; ++x) { const int q = tid + 512 * x, row = q >> 5, cc = q & 31; *(LAS u32x4*)(VL + row * 264 + cc * 8) = pf.v[x]; }
#pragma unroll
    for (int x = 0; x < 2; ++x) { const int q = tid + 512 * x, row = q >> 4, cc = q & 15; *(LAS u32x4*)(QL + row * 136 + cc * 8) = pf.q[x]; *(LAS u32x4*)(KL + row * 136 + cc * 8) = pf.k[x]; }
    float bl[16]; float run = 0.f;
    { float wup[16];
#pragma unroll
      for (int i = 0; i < 16; ++i) wup[i] = p.in[12][i * 512 + h * 128 + cch];
      const float bg = p.in[13][h * 128 + cch];
      asm volatile("s_waitcnt vmcnt(0) lgkmcnt(0)" ::: "memory");
      __syncthreads();
#pragma unroll
      for (int i = 0; i < 16; ++i) { const int j = jq * 16 + i; float x = bg;
#pragma unroll
        for (int r = 0; r < 16; ++r) x += gk_l[j * 16 + r] * wup[r];
        run += logsig16(x); bl[i] = run; } }
    tot[jq * 128 + cch] = run;
    __syncthreads();
    float pre = 0.f, blast = 0.f;
#pragma unroll
    for (int q = 0; q < 4; ++q) { const float t = tot[q * 128 + cch]; blast += t; if (q < jq) pre += t; }
    unsigned kd[8];
#pragma unroll
    for (int i = 0; i < 16; i += 2) { float kdv[2];
#pragma unroll
        for (int e = 0; e < 2; ++e) { const int ii = i + e, j = jq * 16 + ii; const float bb = bl[ii] + pre; const float qraw = bf1(QL[j * 136 + cch]), kraw = bf1(KL[j * 136 + cch]);
            const float qt = qraw * __expf(bb), kt = kraw * __expf(-bb); kdv[e] = kraw * __expf(blast - bb);
            QL[j * 136 + cch] = f2bf(qt); KL[j * 136 + cch] = f2bf(kt); }
        kd[i >> 1] = cvt_pk_bf16(kdv[0], kdv[1]); }
    if (jq == 0) decl[(size_t)item * 128 + cch] = __expf(blast);
    { bf16_t* dst = zA + (size_t)(r0 + (cch >> 1)) * ZLD + 1536 + h * 128 + (cch & 1) * 64 + jq * 16;
      *(u32x4*)dst = (u32x4){kd[0], kd[1], kd[2], kd[3]}; *(u32x4*)(dst + 8) = (u32x4){kd[4], kd[5], kd[6], kd[7]}; }
    __syncthreads();
#pragma unroll
    for (int x = 0; x < 2; ++x) { const int q = tid + 512 * x, row = q >> 4, cc = q & 15;
        *(u32x4*)(zA + (size_t)(r0 + row) * ZLD + 1024 + h * 128 + cc * 8) = *(const LAS u32x4*)(QL + row * 136 + cc * 8); }
    { const int tt = wave >> 1;
#pragma unroll
      for (int x = 0; x < 2; ++x) { const int jt = (wave & 1) * 2 + x; f32x4 a = (f32x4){0.f, 0.f, 0.f, 0.f};
        if (jt <= tt) {
#pragma unroll
            for (int ks = 0; ks < 4; ++ks) { const bf16x8 xk = *(const LAS bf16x8*)(KL + (16 * jt + fr) * 136 + 32 * ks + 8 * fq), yq = *(const LAS bf16x8*)(QL + (16 * tt + fr) * 136 + 32 * ks + 8 * fq);
                a = __builtin_amdgcn_mfma_f32_16x16x32_bf16(xk, yq, a, 0, 0, 0); } }
        const int t = 16 * tt + fr, j0 = 16 * jt + 4 * fq;
#pragma unroll
        for (int r = 0; r < 4; ++r) if (j0 + r > t) a[r] = 0.f;
        *(u32x2*)(At + (size_t)item * 4096 + t * 64 + j0) = pack4(a); } }
#pragma unroll
    for (int x = 0; x < 2; ++x) { const int pi = tid + 512 * x, vv = pi >> 2, j2 = pi & 3; unsigned w[8];
#pragma unroll
        for (int i = 0; i < 8; ++i) { const unsigned lo = VL[(j2 * 16 + 2 * i) * 264 + vv], hi = VL[(j2 * 16 + 2 * i + 1) * 264 + vv]; w[i] = lo | (hi << 16); }
        bf16_t* dst = zA + (size_t)(r0 + (vv >> 2)) * ZLD + 2048 + h * 256 + (vv & 3) * 64 + j2 * 16;
        *(u32x4*)dst = (u32x4){w[0], w[1], w[2], w[3]}; *(u32x4*)(dst + 8) = (u32x4){w[4], w[5], w[6], w[7]}; }
    if (next_item >= 0) prep_prefetch(p, next_item, pf);
    __syncthreads();
}
template <int W>
__device__ __forceinline__ void pool_tile(const bf16_t* zA, bf16_t* pooled, size_t rb, int t0, int c0) {
    unsigned prev[16], cur[16];
#pragma unroll
    for (int i = 0; i < 16; ++i) { const int tt = t0 - 16 + i; prev[i] = (tt >= 0) ? *(const unsigned*)(zA + (rb + tt) * ZLD + c0) : 0u; }
    float s0 = 0.f, s1 = 0.f;
#pragma unroll
    for (int i = 17 - W; i < 16; ++i) { s0 += bf_lo(prev[i]); s1 += bf_hi(prev[i]); }
#pragma unroll 1
    for (int blk = 0; blk < 4; ++blk) { const int tb = t0 + blk * 16;
#pragma unroll
        for (int i = 0; i < 16; ++i) cur[i] = *(const unsigned*)(zA + (rb + tb + i) * ZLD + c0);
#pragma unroll
        for (int i = 0; i < 16; ++i) { const float u0 = bf_lo(cur[i]), u1 = bf_hi(cur[i]); s0 += u0; s1 += u1; const int t = tb + i;
            const float ic = 1.0f / (float)((t + 1 < W) ? (t + 1) : W);
            *(unsigned*)(pooled + (rb + t) * 1024 + c0) = cvt_pk_bf16(s0 * ic - u0, s1 * ic - u1);
            const int k = i - W + 1; const unsigned d = (k >= 0) ? cur[k >= 0 ? k : 0] : prev[k >= 0 ? 0 : 16 + k]; s0 -= bf_lo(d); s1 -= bf_hi(d); }
#pragma unroll
        for (int i = 0; i < 16; ++i) prev[i] = cur[i]; }
}
__device__ __forceinline__ void pool_prompt_item(const Params& p, int item) {
    unsigned char* ws = p.ws; const bf16_t* zA = (const bf16_t*)(ws + OFF_BIG); bf16_t* pooled = (bf16_t*)p.out;
    const int b = item >> 5, n = item & 31, tid = threadIdx.x, c0 = 2 * tid, g = c0 >> 8, t0 = n * 64; const size_t rb = (size_t)b * 2048;
    if (g == 0) pool_tile<2>(zA, pooled, rb, t0, c0); else if (g == 1) pool_tile<4>(zA, pooled, rb, t0, c0); else if (g == 2) pool_tile<8>(zA, pooled, rb, t0, c0); else pool_tile<16>(zA, pooled, rb, t0, c0);
    if (n == 31) { float* np = p.out + OUT_NPP + (size_t)b * 15 * 1024;
#pragma unroll
        for (int i = 0; i < 15; ++i) { const unsigned v = *(const unsigned*)(zA + (rb + 2033 + i) * ZLD + c0); *(f32x2*)(np + i * 1024 + c0) = (f32x2){bf_lo(v), bf_hi(v)}; } }
}
template <int W>
__device__ __forceinline__ void pool_sample_w(const float (&e0)[19], const float (&e1)[19], bf16_t* prow, int c0) {
#pragma unroll
    for (int t = 0; t < 4; ++t) { float s0 = 0.f, s1 = 0.f;
#pragma unroll
        for (int r = 15 + t - W + 1; r <= 15 + t; ++r) { s0 += e0[r]; s1 += e1[r]; }
        *(unsigned*)(prow + (size_t)t * 1024 + c0) = cvt_pk_bf16(s0 * (1.0f / W) - e0[15 + t], s1 * (1.0f / W) - e1[15 + t]); }
}
__device__ __forceinline__ void pool_sample_item(const Params& p, int b) {
    unsigned char* ws = p.ws; const bf16_t* zA = (const bf16_t*)(ws + OFF_BIG); bf16_t* pooled = (bf16_t*)p.out;
    const int tid = threadIdx.x, c0 = 2 * tid, g = c0 >> 8; const float* sp = p.in[4] + (size_t)b * 15 * 1024; const size_t r0 = (size_t)MP + b * 4;
    float e0[19], e1[19];
#pragma unroll
    for (int r = 0; r < 15; ++r) { const f32x2 v = *(const f32x2*)(sp + r * 1024 + c0); e0[r] = v[0]; e1[r] = v[1]; }
#pragma unroll
    for (int t = 0; t < 4; ++t) { const unsigned v = *(const unsigned*)(zA + (r0 + t) * ZLD + c0); e0[15 + t] = bf_lo(v); e1[15 + t] = bf_hi(v); }
    bf16_t* prow = pooled + r0 * 1024;
    if (g == 0) pool_sample_w<2>(e0, e1, prow, c0); else if (g == 1) pool_sample_w<4>(e0, e1, prow, c0); else if (g == 2) pool_sample_w<8>(e0, e1, prow, c0); else pool_sample_w<16>(e0, e1, prow, c0);
    float* np = p.out + OUT_NPS + (size_t)b * 15 * 1024;
#pragma unroll
    for (int i = 0; i < 15; ++i) *(f32x2*)(np + i * 1024 + c0) = (f32x2){e0[i + 4], e1[i + 4]};
}

constexpr int RB_Q = 0, RB_K = 17408, RB_A = 35840, RB_V = 45056, RB_D = 63488, RB_SZ = 65536;
__device__ __forceinline__ void gla_rec_item(const Params& p, LAS unsigned char* lds, int item) {
    unsigned char* ws = p.ws; bf16_t* zA = (bf16_t*)(ws + OFF_BIG); const bf16_t* At = (const bf16_t*)(ws + OFF_AT); const float* decl = (const float*)(ws + OFF_DECL); float* oss = (float*)(ws + OFF_OSS);
    const int quarter = item & 3, h = (item >> 2) & 3, b = item >> 4;
    const int tid = threadIdx.x, lane = tid & 63, wave = tid >> 6, fr = lane & 15, fq = lane >> 4;
    f32x4 S[8];
#pragma unroll
    for (int i = 0; i < 8; ++i) S[i] = (f32x4){0.f, 0.f, 0.f, 0.f};
    u32x4 rqA[2], rkA[2], raA, rvA, rqB[2], rkB[2], raB, rvB; f32x4 rdA = (f32x4){0.f, 0.f, 0.f, 0.f}, rdB = (f32x4){0.f, 0.f, 0.f, 0.f};
#define REC_LOAD(T, nn) do { const int r0_ = b * 2048 + (nn) * 64; const size_t it_ = (size_t)((b * 32 + (nn)) * 4 + h); \
        _Pragma("unroll") for (int x = 0; x < 2; ++x) { const int id = tid + 512 * x; \
            rq##T[x] = *(const u32x4*)(zA + (size_t)(r0_ + (id >> 4)) * ZLD + 1024 + h * 128 + (id & 15) * 8); \
            rk##T[x] = *(const u32x4*)(zA + (size_t)(r0_ + (id >> 4)) * ZLD + 1536 + h * 128 + (id & 15) * 8); \
            } \
        rv##T = *(const u32x4*)(zA + (size_t)(r0_ + 16 * quarter + (tid >> 5)) * ZLD + 2048 + h * 256 + (tid & 31) * 8); \
        ra##T = *(const u32x4*)(At + it_ * 4096 + (tid >> 3) * 64 + (tid & 7) * 8); \
        if (tid < 32) rd##T = *(const f32x4*)(decl + it_ * 128 + tid * 4); } while (0)
#define REC_STORE(T, buf) do { LAS unsigned char* B_ = lds + (buf) * RB_SZ; \
        _Pragma("unroll") for (int x = 0; x < 2; ++x) { const int id = tid + 512 * x; \
            *(LAS u32x4*)(B_ + RB_Q + (id >> 4) * 272 + (id & 15) * 16) = rq##T[x]; \
            *(LAS u32x4*)(B_ + RB_K + (2 * (id >> 4) + ((id & 15) >> 3)) * 144 + (id & 7) * 16) = rk##T[x]; \
            } \
        *(LAS u32x4*)(B_ + RB_V + (4 * (tid >> 5) + ((tid & 31) >> 3)) * 144 + (tid & 7) * 16) = rv##T; \
        *(LAS u32x4*)(B_ + RB_A + (tid >> 3) * 144 + (tid & 7) * 16) = ra##T; \
        if (tid < 32) *(LAS f32x4*)(B_ + RB_D + tid * 16) = rd##T; } while (0)
#define REC_STEP(n) do { \
        const LAS unsigned char* B = lds + ((n) & 1) * RB_SZ; const int r0 = b * 2048 + (n) * 64; \
        bf16x8 vt[2]; u32x2 qf[4][4][2]; bf16x8 af[4][2]; \
        _Pragma("unroll") for (int jk = 0; jk < 2; ++jk) vt[jk] = *(const LAS bf16x8*)(B + RB_V + (16 * wave + fr) * 144 + (32 * jk + 8 * fq) * 2); \
        _Pragma("unroll") for (int tt = 0; tt < 4; ++tt) { \
            _Pragma("unroll") for (int cp = 0; cp < 4; ++cp) { const LAS unsigned char* qa = B + RB_Q + (16 * tt + fr) * 272 + (32 * cp + 4 * fq) * 2; qf[tt][cp][0] = *(const LAS u32x2*)qa; qf[tt][cp][1] = *(const LAS u32x2*)(qa + 32); } \
            _Pragma("unroll") for (int jk = 0; jk < 2; ++jk) af[tt][jk] = *(const LAS bf16x8*)(B + RB_A + (16 * tt + fr) * 144 + (32 * jk + 8 * fq) * 2); } \
        bf16x8 sop[4]; \
        _Pragma("unroll") for (int cp = 0; cp < 4; ++cp) { u32x4 w; w.x = cvt_pk_bf16(S[2 * cp][0], S[2 * cp][1]); w.y = cvt_pk_bf16(S[2 * cp][2], S[2 * cp][3]); w.z = cvt_pk_bf16(S[2 * cp + 1][0], S[2 * cp + 1][1]); w.w = cvt_pk_bf16(S[2 * cp + 1][2], S[2 * cp + 1][3]); \
            sop[cp] = __builtin_bit_cast(bf16x8, w); } \
        f32x4 o[4]; \
        _Pragma("unroll") for (int tt = 0; tt < 4; ++tt) o[tt] = (f32x4){0.f, 0.f, 0.f, 0.f}; \
        _Pragma("unroll") for (int cp = 0; cp < 4; ++cp) \
            _Pragma("unroll") for (int tt = 0; tt < 4; ++tt) { const u32x4 qw = (u32x4){qf[tt][cp][0].x, qf[tt][cp][0].y, qf[tt][cp][1].x, qf[tt][cp][1].y}; \
                o[tt] = __builtin_amdgcn_mfma_f32_16x16x32_bf16(sop[cp], __builtin_bit_cast(bf16x8, qw), o[tt], 0, 0, 0); } \
        _Pragma("unroll") for (int jk = 0; jk < 2; ++jk) \
            _Pragma("unroll") for (int tt = 0; tt < 4; ++tt) o[tt] = __builtin_amdgcn_mfma_f32_16x16x32_bf16(vt[jk], af[tt][jk], o[tt], 0, 0, 0); \
        __builtin_amdgcn_sched_barrier(0); \
        _Pragma("unroll") for (int tt = 0; tt < 4; ++tt) { const int row = r0 + 16 * tt + fr; \
            *(u32x2*)(zA + (size_t)row * ZLD + h * 256 + quarter * 64 + wave * 16 + 4 * fq) = pack4(o[tt]); \
            float sq = (o[tt][0] * o[tt][0] + o[tt][1] * o[tt][1]) + (o[tt][2] * o[tt][2] + o[tt][3] * o[tt][3]); sq += __shfl_xor(sq, 16); sq += __shfl_xor(sq, 32); \
            if (fq == 0) oss[(size_t)row * 64 + h * 16 + quarter * 4 + wave] = sq; } \
        _Pragma("unroll") for (int hf = 0; hf < 2; ++hf) { bf16x8 kf[4][2]; f32x4 dv[4]; \
            _Pragma("unroll") for (int c4 = 0; c4 < 4; ++c4) { const int ct = hf * 4 + c4; dv[c4] = *(const LAS f32x4*)(B + RB_D + (16 * ct + 4 * fq) * 4); \
                _Pragma("unroll") for (int jk = 0; jk < 2; ++jk) kf[c4][jk] = *(const LAS bf16x8*)(B + RB_K + (16 * ct + fr) * 144 + (32 * jk + 8 * fq) * 2); } \
            _Pragma("unroll") for (int c4 = 0; c4 < 4; ++c4) S[hf * 4 + c4] = S[hf * 4 + c4] * dv[c4]; \
            _Pragma("unroll") for (int jk = 0; jk < 2; ++jk) \
                _Pragma("unroll") for (int c4 = 0; c4 < 4; ++c4) S[hf * 4 + c4] = __builtin_amdgcn_mfma_f32_16x16x32_bf16(kf[c4][jk], vt[jk], S[hf * 4 + c4], 0, 0, 0); \
            __builtin_amdgcn_sched_barrier(0); } \
        } while (0)
    REC_LOAD(A, 0); REC_STORE(A, 0); REC_LOAD(B, 1);
    __syncthreads();
#pragma unroll 1
    for (int n = 0; n < 32; n += 2) {
        if (n + 2 < 32) REC_LOAD(A, n + 2);
        if (wave < 4) REC_STEP(n);
        REC_STORE(B, 1);
        __syncthreads();
        if (n + 3 < 32) REC_LOAD(B, n + 3);
        if (wave < 4) REC_STEP(n + 1);
        if (n + 2 < 32) REC_STORE(A, 0);
        __syncthreads();
    }
#undef REC_LOAD
#undef REC_STORE
#undef REC_STEP
    if (wave >= 4) return;
    float* so = p.out + OUT_NGP + (size_t)(b * 4 + h) * 128 * 256 + quarter * 64 + wave * 16 + fr;
#pragma unroll
    for (int ct = 0; ct < 8; ++ct)
#pragma unroll
        for (int r = 0; r < 4; ++r) so[(size_t)(16 * ct + 4 * fq + r) * 256] = S[ct][r];
}
__device__ __forceinline__ void gla_sample_item(const Params& p, LAS unsigned char* lds, int item) {
    unsigned char* ws = p.ws; bf16_t* zA = (bf16_t*)(ws + OFF_BIG); const float* gklr = (const float*)(ws + OFF_GKLR); float* oss = (float*)(ws + OFF_OSS);
    const int b = item >> 2, h = item & 3, r0 = MP + b * 4; const int tid = threadIdx.x, lane = tid & 63, wave = tid >> 6;
    LAS float* qe = (LAS float*)lds;
    LAS float* ke = qe + 512;
    LAS float* dl = ke + 512;
    LAS float* Ap = dl + 128;
    LAS float* vl = Ap + 32;
    LAS float* op = vl + 1024;
    for (int i = tid; i < 1024; i += 512) vl[i] = bf1(zA[(size_t)(r0 + (i >> 8)) * ZLD + 2048 + h * 256 + (i & 255)]);
    LAS float* gkl = op;
    if (tid >= 448) gkl[tid - 448] = gklr[(size_t)r0 * 16 + (tid - 448)];
    __syncthreads();
    if (tid < 128) { const int c = tid; float bl[4], qv[4], kv[4]; float run = 0.f; const float bg = p.in[13][h * 128 + c];
        float wup[16];
#pragma unroll
        for (int r = 0; r < 16; ++r) wup[r] = p.in[12][r * 512 + h * 128 + c];
#pragma unroll
        for (int t = 0; t < 4; ++t) { float x = bg;
#pragma unroll
            for (int r = 0; r < 16; ++r) x += gkl[t * 16 + r] * wup[r];
            run += logsig16(x); bl[t] = run; qv[t] = bf1(zA[(size_t)(r0 + t) * ZLD + 1024 + h * 128 + c]); kv[t] = bf1(zA[(size_t)(r0 + t) * ZLD + 1536 + h * 128 + c]); }
#pragma unroll
        for (int t = 0; t < 4; ++t) { qe[t * 128 + c] = qv[t] * __expf(bl[t]); ke[t * 128 + c] = kv[t] * __expf(bl[3] - bl[t]); }
        dl[c] = __expf(bl[3]);
#pragma unroll
        for (int i = 0; i < 4; ++i)
#pragma unroll
            for (int j = 0; j < 4; ++j) { float v = (j <= i) ? qv[i] * kv[j] * __expf(bl[i] - bl[j]) : 0.f; v = wave_sum(v); if (lane == 0) Ap[wave * 16 + i * 4 + j] = v; }
    }
    __syncthreads();
    const int vq = tid & 63, cp = tid >> 6;
    const float* S0 = p.in[5] + (size_t)item * 128 * 256; float* Sn = p.out + OUT_NGS + (size_t)item * 128 * 256;
    f32x4 vv[4];
#pragma unroll
    for (int j = 0; j < 4; ++j) vv[j] = *(const LAS f32x4*)(vl + j * 256 + vq * 4);
    f32x4 oa[4];
#pragma unroll
    for (int i = 0; i < 4; ++i) oa[i] = (f32x4){0.f, 0.f, 0.f, 0.f};
#pragma unroll 1
    for (int c8 = 0; c8 < 2; ++c8) {
    f32x4 s0r[8];
#pragma unroll
    for (int cc = 0; cc < 8; ++cc) s0r[cc] = __builtin_nontemporal_load((const f32x4*)(S0 + (size_t)(cp * 16 + c8 * 8 + cc) * 256 + vq * 4));
#pragma unroll
    for (int cc = 0; cc < 8; ++cc) { const int c = cp * 16 + c8 * 8 + cc; const f32x4 s = s0r[cc];
        f32x4 sn = s * dl[c];
#pragma unroll
        for (int j = 0; j < 4; ++j) sn += vv[j] * ke[j * 128 + c];
        *(f32x4*)(Sn + (size_t)c * 256 + vq * 4) = sn;
#pragma unroll
        for (int i = 0; i < 4; ++i) oa[i] += s * qe[i * 128 + c]; }
    }
#pragma unroll
    for (int i = 0; i < 4; ++i) *(LAS f32x4*)(op + (cp * 4 + i) * 256 + vq * 4) = oa[i];
    __syncthreads();
    if (tid < 256) { const int i = tid >> 6; f32x4 o = (f32x4){0.f, 0.f, 0.f, 0.f};
#pragma unroll
        for (int q = 0; q < 8; ++q) o += *(const LAS f32x4*)(op + (q * 4 + i) * 256 + vq * 4);
#pragma unroll
        for (int j = 0; j < 4; ++j) if (j <= i) o += vv[j] * (Ap[i * 4 + j] + Ap[16 + i * 4 + j]);
        *(u32x2*)(zA + (size_t)(r0 + i) * ZLD + h * 256 + vq * 4) = pack4(o);
        float sq = (o[0] * o[0] + o[1] * o[1]) + (o[2] * o[2] + o[3] * o[3]); sq = wave_sum(sq);
        if (lane < 16) oss[(size_t)(r0 + i) * 64 + h * 16 + lane] = (lane == 0) ? sq : 0.f; }
    __syncthreads();
}

__device__ __forceinline__ void conv_ffn2_idle(const Params& p, LAS unsigned char* lds, int G, int bid, int part, int nbusy) {
    if (bid < nbusy) return;
    const int tid = threadIdx.x; conv_ffn(p, 18, (bf16_t*)((unsigned char*)p.out + Y_FFN2_OFF), (LAS float*)(lds + (tid >> 6) * 16384), (bid - nbusy) * 8 + (tid >> 6), (G - nbusy) * 8, tid & 63, part);
}


template <class SE>
__device__ __forceinline__ void sample_gemm(const bf16_t* A, int lda, int a_pn_off, const bf16_t* Bt, int ldb, int K, int piece, const SE& E, LAS unsigned char* lds) {
    const int tid = threadIdx.x, lane = tid & 63, w8 = tid >> 6, w = w8 & 3, kh = w8 >> 2, mi = w >> 1, gi = w & 1, fr = lane & 15, fq = lane >> 4;
    const int mt2 = piece >> 4, cch = piece & 15, pn = cch >> 2, grp = 2 * (cch & 3) + gi;
    const int row = MP + 32 * mt2 + 16 * mi + fr, Kh = K >> 1;
    const bf16_t* ap = A + (size_t)row * lda + pn * a_pn_off + kh * Kh + 8 * fq;
    const bf16_t* bp0 = Bt + (size_t)(256 * pn + 32 * grp + fr) * ldb + kh * Kh + 8 * fq; const bf16_t* bp1 = bp0 + (size_t)16 * ldb;
    f32x4 acc0 = (f32x4){0.f, 0.f, 0.f, 0.f}, acc1 = (f32x4){0.f, 0.f, 0.f, 0.f};
    bf16x8 aA[4], b0A[4], b1A[4], aB[4], b0B[4], b1B[4];
#define SG_LD(T, kk) do { _Pragma("unroll") for (int j = 0; j < 4; ++j) { a##T[j] = *(const bf16x8*)(ap + (kk) + 32 * j); b0##T[j] = *(const bf16x8*)(bp0 + (kk) + 32 * j); b1##T[j] = *(const bf16x8*)(bp1 + (kk) + 32 * j); } } while (0)
#define SG_MM(T) do { _Pragma("unroll") for (int j = 0; j < 4; ++j) { acc0 = __builtin_amdgcn_mfma_f32_16x16x32_bf16(b0##T[j], a##T[j], acc0, 0, 0, 0); acc1 = __builtin_amdgcn_mfma_f32_16x16x32_bf16(b1##T[j], a##T[j], acc1, 0, 0, 0); } } while (0)
    SG_LD(A, 0);
#pragma unroll 1
    for (int k = 0; k < Kh; k += 256) {
        if (k + 128 < Kh) SG_LD(B, k + 128);
        SG_MM(A);
        if (k + 256 < Kh) SG_LD(A, k + 256);
        if (k + 128 < Kh) SG_MM(B);
    }
#undef SG_LD
#undef SG_MM
    LAS f32x4* xch = (LAS f32x4*)(lds + 4096);
    __syncthreads();
    if (kh == 1) { xch[(w * 64 + lane) * 2] = acc0; xch[(w * 64 + lane) * 2 + 1] = acc1; }
    __syncthreads();
    if (kh == 0) { acc0 += xch[(w * 64 + lane) * 2]; acc1 += xch[(w * 64 + lane) * 2 + 1]; }
    E(kh == 0, row, 256 * pn + 32 * grp + 8 * fq, pn, cch & 3, w, fr, fq, acc0, acc1, lds);
}
__device__ __forceinline__ void sample_ss(bool act, float sq, int row, int pn, int slot, int w, int fr, int fq, float* ssw, LAS unsigned char* lds) {
    LAS float* t = (LAS float*)lds; sq += __shfl_xor(sq, 16); sq += __shfl_xor(sq, 32);
    __syncthreads();
    if (act && fq == 0) t[w * 16 + fr] = sq;
    __syncthreads();
    if (act && fq == 0 && (w & 1) == 0) ssw[(size_t)row * 16 + pn * 4 + slot] = t[w * 16 + fr] + t[(w + 1) * 16 + fr];
}
struct SEpiResid { bf16_t* hb; float* ssw; float scale;
    __device__ __forceinline__ void operator()(bool act, int row, int c0, int pn, int slot, int w, int fr, int fq, f32x4 a0, f32x4 a1, LAS unsigned char* lds) const {
        bf16_t* hp = hb + (size_t)row * 1024 + c0; f32x4 v0 = (f32x4){0.f, 0.f, 0.f, 0.f}, v1 = v0;
        if (act) { const u32x4 r = *(const u32x4*)hp; v0 = unpack_lo(r) + a0 * scale; v1 = unpack_hi(r) + a1 * scale; *(u32x4*)hp = pack8(v0, v1); }
        sample_ss(act, ((v0[0] * v0[0] + v0[1] * v0[1]) + (v0[2] * v0[2] + v0[3] * v0[3])) + ((v1[0] * v1[0] + v1[1] * v1[1]) + (v1[2] * v1[2] + v1[3] * v1[3])), row, pn, slot, w, fr, fq, ssw, lds);
    } };
struct SEpiMix { bf16_t* sga; const bf16_t* P; const bf16_t* o; const float* oss;
    __device__ __forceinline__ void operator()(bool act, int row, int c0, int pn, int slot, int w, int fr, int fq, f32x4 a0, f32x4 a1, LAS unsigned char* lds) const {
        if (!act) return;
        const float rso = 1.0f / sqrtf(sum16(oss + (size_t)row * 64 + pn * 16) * (1.0f / 256.0f) + EPS);
        bf16_t* sp = sga + (size_t)row * 1024 + c0; const u32x4 sg = *(const u32x4*)sp, pv = *(const u32x4*)(P + (size_t)row * 1024 + c0), ov = *(const u32x4*)(o + (size_t)row * ZLD + c0);
        *(u32x4*)sp = pack8(unpack_lo(sg) * a0 + unpack_lo(pv) * (unpack_lo(ov) * rso), unpack_hi(sg) * a1 + unpack_hi(pv) * (unpack_hi(ov) * rso));
    } };
struct SEpiBf16 { bf16_t* out;
    __device__ __forceinline__ void operator()(bool act, int row, int c0, int pn, int slot, int w, int fr, int fq, f32x4 a0, f32x4 a1, LAS unsigned char* lds) const { if (act) *(u32x4*)(out + (size_t)row * 1024 + c0) = pack8(a0, a1); } };
struct SEpiPle { bf16_t* h; const bf16_t* hb; const bf16_t* pp; const float* ss; float* ssw;
    __device__ __forceinline__ void operator()(bool act, int row, int c0, int pn, int slot, int w, int fr, int fq, f32x4 a0, f32x4 a1, LAS unsigned char* lds) const {
        f32x4 v0 = (f32x4){0.f, 0.f, 0.f, 0.f}, v1 = v0;
        if (act) { const float rs = rowscale(ss, row, 1.0f / 1024.0f); const u32x4 hv = *(const u32x4*)(hb + (size_t)row * 1024 + c0), pv = *(const u32x4*)(pp + (size_t)row * 1024 + c0);
            v0 = unpack_lo(hv) + sigmoid4(a0 * rs) * unpack_lo(pv); v1 = unpack_hi(hv) + sigmoid4(a1 * rs) * unpack_hi(pv);
            *(u32x4*)(h + (size_t)row * 1024 + c0) = pack8(v0, v1); }
        sample_ss(act, ((v0[0] * v0[0] + v0[1] * v0[1]) + (v0[2] * v0[2] + v0[3] * v0[3])) + ((v1[0] * v1[0] + v1[1] * v1[1]) + (v1[2] * v1[2] + v1[3] * v1[3])), row, pn, slot, w, fr, fq, ssw, lds);
    } };

#define XB_TMO      128
#define XB_XCNT(j)  (256  + 64 * (j))
#define XB_XSUB(j)  (1280 + 64 * (j))
#define XB_XGEN(j)  (2304 + 64 * (j))
#define XB_TOP      3328
#define XB_TOPGEN   3392
#define XCD_BAR_WORDS 3456
#define XB_SPIN_CAP (1u << 18)
__device__ __forceinline__ unsigned xb_ld(unsigned* p)              { return __hip_atomic_load(p, __ATOMIC_RELAXED, __HIP_MEMORY_SCOPE_AGENT); }
__device__ __forceinline__ unsigned xb_add(unsigned* p, unsigned v) { return __hip_atomic_fetch_add(p, v, __ATOMIC_RELAXED, __HIP_MEMORY_SCOPE_AGENT); }
__device__ __forceinline__ unsigned xb_xcc_id() { return (unsigned)__builtin_amdgcn_s_getreg((3 << 11) | 20) & 0xFu; }
#define XB_SPIN(cond, bar) do { unsigned _sp = 0; while (cond) { __builtin_amdgcn_s_sleep(1); \
    if ((++_sp & 255u) == 0u) { if (xb_ld(&(bar)[XB_TMO])) break; if (_sp > XB_SPIN_CAP) { atomicAdd(&(bar)[XB_TMO], 1u); break; } } } } while (0)
struct XcdBarrier { unsigned* bar; unsigned x; volatile LAS unsigned* st; };
__device__ __forceinline__ XcdBarrier xcd_barrier_post(unsigned* bar, volatile LAS unsigned* st) {
    XcdBarrier b; b.bar = bar; b.x = xb_xcc_id(); b.st = st;
    if (threadIdx.x == 0) (void)xb_add(&bar[XB_XCNT(b.x)], 1u);
    return b;
}
__device__ __forceinline__ void xcd_barrier_complete(unsigned* bar, unsigned x, unsigned& nloc, unsigned& nx) {
    const unsigned G = gridDim.x * gridDim.y * gridDim.z;
    unsigned sum, cnt, mine, sp = 0u;
    for (;;) {
        sum = 0u; cnt = 0u; mine = 0u;
#pragma unroll
        for (unsigned j = 0; j < 16; ++j) { const unsigned c = xb_ld(&bar[XB_XCNT(j)]); sum += c; cnt += (c > 0u) ? 1u : 0u; mine = (j == x) ? c : mine; }
        if (sum == G) break;
        __builtin_amdgcn_s_sleep(1);
        if ((++sp & 255u) == 0u) { if (xb_ld(&bar[XB_TMO])) break; if (sp > XB_SPIN_CAP) { atomicAdd(&bar[XB_TMO], 1u); break; } }
    }
    nloc = mine > 0u ? mine : 1u; nx = cnt > 0u ? cnt : 1u;
}
__device__ __forceinline__ void xcd_barrier(const XcdBarrier& b) {
    asm volatile("s_waitcnt vmcnt(0)" ::: "memory");
    __syncthreads();
    if (threadIdx.x == 0) {
        unsigned* bar = b.bar;
        __builtin_amdgcn_s_waitcnt(0);
        unsigned nloc = b.st[0], nx = b.st[1];
        if (nloc == 0u) { xcd_barrier_complete(bar, b.x, nloc, nx); b.st[0] = nloc; b.st[1] = nx; }
        const unsigned old = xb_add(&bar[XB_XSUB(b.x)], 1u);
        const unsigned gen = old / nloc;
        if (old + 1u == (gen + 1u) * nloc) {
            __builtin_amdgcn_fence(__ATOMIC_RELEASE, "agent");
            asm volatile("s_waitcnt vmcnt(0)" ::: "memory");
            const unsigned og = xb_add(&bar[XB_TOP], 1u);
            const unsigned tg = og / nx;
            if (og + 1u == (tg + 1u) * nx) xb_add(&bar[XB_TOPGEN], 1u);
            else XB_SPIN(xb_ld(&bar[XB_TOPGEN]) == tg, bar);
            __builtin_amdgcn_fence(__ATOMIC_ACQUIRE, "agent");
            xb_add(&bar[XB_XGEN(b.x)], 1u);
            asm volatile("s_waitcnt vmcnt(0)" ::: "memory");
        } else {
            XB_SPIN(xb_ld(&bar[XB_XGEN(b.x)]) == gen, bar);
            __builtin_amdgcn_fence(__ATOMIC_ACQUIRE, "agent");
            asm volatile("s_waitcnt vmcnt(0)" ::: "memory");
        }
    }
    __syncthreads();
}
__global__ void __launch_bounds__(512, 2) fwd_megakernel(Params p) {
    extern __shared__ __attribute__((aligned(16))) unsigned char lds_raw[];
    LAS unsigned char* lds = (LAS unsigned char*)lds_raw;
    cg::grid_group grid = cg::this_grid();
    unsigned char* ws = p.ws; const int G = gridDim.x, bid = blockIdx.x;
    bf16_t* hb = (bf16_t*)(ws + OFF_HB); bf16_t* big = (bf16_t*)(ws + OFF_BIG); bf16_t* sga = (bf16_t*)(ws + OFF_SGA); bf16_t* Pb = (bf16_t*)(ws + OFF_P);
    float* ssa = (float*)(ws + OFF_SSA); float* ssb = (float*)(ws + OFF_SSB); float* hres = p.out;
    const bf16_t* w1t = (const bf16_t*)(ws + OFF_WFFN); const bf16_t* w2t = (const bf16_t*)(ws + OFF_WFFN + SZ_W1T);
    const int lo = p.ph_lo, hi = p.ph_hi;
#ifndef PHMASK
#define PHMASK 0xFFF
#endif
#define IN(k) (((PHMASK >> (k)) & 1) && lo <= (k) && (k) < hi)
#define SEAM0() do { if (IN(0) && IN(1)) { asm volatile("s_waitcnt vmcnt(0) lgkmcnt(0)" ::: "memory"); grid.sync(); if (threadIdx.x < 64) { __builtin_amdgcn_fence(__ATOMIC_ACQUIRE, "agent"); asm volatile("s_waitcnt vmcnt(0)" ::: "memory"); } __syncthreads(); } } while (0)
#define SEAM(k) do { if (IN(k) && IN((k) + 1)) xcd_barrier(xbar); } while (0)
    unsigned* barw = (unsigned*)ws + 1024; volatile LAS unsigned* bst = (volatile LAS unsigned*)(lds + RS_OFF + 15360);
    if (threadIdx.x < 2) bst[threadIdx.x] = 0u;
    XcdBarrier xbar; xbar.bar = barw; xbar.x = 0; xbar.st = bst;
    if (lo == 0 && hi == NPH) xbar = xcd_barrier_post(barw, bst);
    if (lo < 0) grid.sync();
    if (IN(0)) phase_prep(p, lds);
    SEAM(0);
    if (IN(1)) { pg8::Gemm g{hb, w1t, 1024, 1024, 1024, 0}; pg8::StaticOrder S; S.init(M, 5632, G, bid); EpiSwiglu E{big, (const LAS float*)(lds + RS_OFF)}; pg8::gemm_phase(lds, g, S, E, PreRs{lds, &S, ssa});
        const int nb = (66 * 22) % G; if (bid >= nb) conv_rest(p, lds, (bid - nb) * 8 + (threadIdx.x >> 6), (G - nb) * 8); }
    SEAM(1);
    if (IN(2)) { pg8::Gemm g{big, w2t, FF, FF, FF, 0}; pg8::StaticOrder S; S.init(MP, 1024, G, bid); EpiResid E{hb, ssb, 0.5f}; pg8::gemm_phase(lds, g, S, E);
        for (int pc = bid; pc < 256; pc += G) { SEpiResid SE{hb, ssb, 0.5f}; sample_gemm(big, FF, 0, w2t, FF, FF, pc, SE, lds); }
    }
    SEAM(2);
    if (IN(3)) { pg8::Gemm g{hb, (const bf16_t*)(ws + OFF_WIN), 1024, 1024, 1024, 0}; pg8::StaticOrder S; S.init(M, NIN, G, bid);
        EpiZ E{big, sga, Pb, (float*)(ws + OFF_GKLR), (const LAS float*)(lds + RS_OFF), p.in[14]}; pg8::gemm_phase(lds, g, S, E, PreRs{lds, &S, ssb});
        conv_ffn2_idle(p, lds, G, bid, 0, (66 * 25) % G); }
    SEAM(3);
    if (IN(4)) {
        { PrepPf pf; if (bid < 1024) prep_prefetch(p, bid, pf);
          for (int it = bid; it < 1024; it += G) gla_prep_item(p, lds, it, pf, (it + G < 1024) ? it + G : -1); }
        int it0 = bid; while (it0 < 1024) it0 += G;
        for (int it = it0; it < 1024 + 256 + 128; it += G) {
            if (it < 1280) pool_prompt_item(p, it - 1024);
            else pool_sample_item(p, it - 1280);
        }
    }
    SEAM(4);
    if (IN(5)) {
        if (G >= 192) { if (bid < 128) gla_rec_item(p, lds, bid); else for (int it = bid - 128; it < 512; it += G - 128) gla_sample_item(p, lds, it); }
        else for (int it = bid; it < 640; it += G) { if (it < 128) gla_rec_item(p, lds, it); else gla_sample_item(p, lds, it - 128); }
    }
    SEAM(5);
    if (IN(6)) { pg8::Gemm g{(const bf16_t*)p.out, (const bf16_t*)(ws + OFF_WPT), 256, 1024, 256, 512}; pg8::StaticOrder S; S.init(MP, 1024, G, bid);
        EpiMix E{sga, Pb, big, (const LAS float*)(lds + RS_OFF)}; pg8::gemm_phase(lds, g, S, E, PreRso{lds, &S, (const float*)(ws + OFF_OSS)});
        for (int pc = bid; pc < 256; pc += G) { SEpiMix SE{sga, Pb, big, (const float*)(ws + OFF_OSS)}; sample_gemm((const bf16_t*)p.out, 1024, 256, (const bf16_t*)(ws + OFF_WPT), 256, 256, pc, SE, lds); }
    }
    SEAM(6);
    if (IN(7)) {
        pg8::Gemm g{sga, (const bf16_t*)(ws + OFF_WOUT), 1024, 1024, 1024, 0}; pg8::StaticOrder S; S.init(MP, 1024, G, bid);
        EpiResid E{hb, ssa, 1.0f}; pg8::gemm_phase(lds, g, S, E);
        for (int pc = bid; pc < 256; pc += G) { SEpiResid SE{hb, ssa, 1.0f}; sample_gemm(sga, 1024, 0, (const bf16_t*)(ws + OFF_WOUT), 1024, 1024, pc, SE, lds); }
    }
    SEAM(7);
    const bf16_t* w1t2 = (const bf16_t*)((const unsigned char*)p.out + Y_FFN2_OFF); const bf16_t* w2t2 = w1t2 + SZ_W1T / 2;
    if (IN(8)) { pg8::Gemm g{hb, w1t2, 1024, 1024, 1024, 0}; pg8::StaticOrder S; S.init(M, 5632, G, bid); EpiSwiglu E{big, (const LAS float*)(lds + RS_OFF)}; pg8::gemm_phase(lds, g, S, E, PreRs{lds, &S, ssa}); }
    SEAM(8);
    if (IN(9)) {
        { pg8::Gemm g{big, w2t2, FF, FF, FF, 0}; pg8::StaticOrder S; S.init(MP, 1024, G, bid); EpiResid E{hb, ssb, 0.5f}; pg8::gemm_phase(lds, g, S, E); }
        { pg8::Gemm g{(const bf16_t*)(ws + OFF_PB), (const bf16_t*)(ws + OFF_WPP), 256, 256, 256, 0}; pg8::StaticOrder S; S.init(MP, 1024, G, bid); EpiBf16 E{Pb}; pg8::gemm_phase(lds, g, S, E); }
        for (int pc = bid; pc < 256; pc += G) { SEpiResid SE{hb, ssb, 0.5f}; sample_gemm(big, FF, 0, w2t2, FF, FF, pc, SE, lds); }
        for (int pc = G - 1 - bid; pc < 256; pc += G) { SEpiBf16 SE{Pb}; sample_gemm((const bf16_t*)(ws + OFF_PB), 256, 0, (const bf16_t*)(ws + OFF_WPP), 256, 256, pc, SE, lds); }
    }
    SEAM(9);
    if (IN(10)) { pg8::Gemm g{hb, (const bf16_t*)(ws + OFF_WPG), 1024, 1024, 1024, 0}; pg8::StaticOrder S; S.init(MP, 1024, G, bid); EpiPle E{sga, hb, Pb, (const LAS float*)(lds + RS_OFF), ssa}; pg8::gemm_phase(lds, g, S, E, PreRs{lds, &S, ssb});
        for (int pc = bid; pc < 256; pc += G) { SEpiPle SE{sga, hb, Pb, ssb, ssa}; sample_gemm(hb, 1024, 0, (const bf16_t*)(ws + OFF_WPG), 1024, 1024, pc, SE, lds); } }
    SEAM(10);
    if (IN(11)) {
        const int tid = threadIdx.x, lane = tid & 63, gw = bid * 8 + (tid >> 6), NGW = G * 8;
        for (int row = gw; row < M; row += NGW) { const float rs = rowscale(ssa, row, 1.0f / 1024.0f); float* hr = hres + (size_t)row * 1024; const bf16_t* h4 = sga + (size_t)row * 1024;
#pragma unroll
            for (int j = 0; j < 2; ++j) { const u32x4 v = *(const u32x4*)(h4 + j * 512 + lane * 8); const f32x4 f0 = *(const f32x4*)(p.in[25] + j * 512 + lane * 8), f1 = *(const f32x4*)(p.in[25] + j * 512 + lane * 8 + 4);
                *(f32x4*)(hr + j * 512 + lane * 8) = unpack_lo(v) * rs * f0; *(f32x4*)(hr + j * 512 + lane * 8 + 4) = unpack_hi(v) * rs * f1; } }
    }

#ifdef DUMP
    { asm volatile("s_waitcnt vmcnt(0) lgkmcnt(0)" ::: "memory"); grid.sync(); __builtin_amdgcn_fence(__ATOMIC_ACQUIRE, "agent"); asm volatile("s_waitcnt vmcnt(0)" ::: "memory");
      const size_t n = (size_t)M * 1024;
      for (size_t i = (size_t)bid * 512 + threadIdx.x; i < n; i += (size_t)G * 512) { const size_t row = i >> 10, col = i & 1023;
#if DUMP == 1
        hres[i] = bf1(sga[i]);
#elif DUMP == 2
        hres[i] = bf1(hb[i]); (void)row; (void)col;
#elif DUMP == 3
        hres[i] = bf1(Pb[i]); if (row < MP) p.out[OUT_NGS + i] = ((const float*)(ws + OFF_OSS))[row * 64 + (col & 63)];
#endif
      } }
#endif
#undef IN
#undef SEAM
}


#ifndef MK_SPLIT
#define MK_SPLIT 0
#endif
extern "C" void kernel_launch(void* const* d_in, const int* in_sizes, int n_in, void* d_out, int out_size, void* d_ws, size_t ws_size, hipStream_t stream) {
    static int grid_blocks = 0;
    if (!grid_blocks) {
        int dev = 0, cus = 0, per_cu = 0;
        hipGetDevice(&dev); hipDeviceGetAttribute(&cus, hipDeviceAttributeMultiprocessorCount, dev);
        hipFuncSetAttribute((const void*)fwd_megakernel, hipFuncAttributeMaxDynamicSharedMemorySize, LDS_BYTES);
        hipOccupancyMaxActiveBlocksPerMultiprocessor(&per_cu, (const void*)fwd_megakernel, 512, LDS_BYTES);
        if (per_cu < 1) { fprintf(stderr, "kernel_launch: occupancy query says %d blocks per CU\n", per_cu); per_cu = 1; }
        if (per_cu > 1) per_cu = 1;
        grid_blocks = cus * per_cu;
        if (ws_size < WS_END) fprintf(stderr, "kernel_launch: workspace too small (%zu < %zu)\n", ws_size, (size_t)WS_END);
    }
#ifdef DIAG_MEMSET
    hipMemsetAsync(d_ws, 0xAA, WS_END, stream);
#endif
    (void)hipMemsetAsync((unsigned char*)d_ws + 4096, 0, XCD_BAR_WORDS * 4, stream);
    Params p{};
    for (int i = 0; i < 26; ++i) p.in[i] = (const float*)d_in[i];
    p.out = (float*)d_out; p.ws = (unsigned char*)d_ws;
#if MK_SPLIT
    for (int ph = 0; ph < NPH; ++ph) { p.ph_lo = ph; p.ph_hi = ph + 1; void* args[] = {&p};
        hipError_t e = hipLaunchCooperativeKernel((const void*)fwd_megakernel, dim3(grid_blocks), dim3(512), args, LDS_BYTES, stream);
        if (e != hipSuccess) fprintf(stderr, "launch %d failed: %s\n", ph, hipGetErrorString(e)); }
#else
    p.ph_lo = 0; p.ph_hi = NPH; void* args[] = {&p};
    hipError_t e = hipLaunchCooperativeKernel((const void*)fwd_megakernel, dim3(grid_blocks), dim3(512), args, LDS_BYTES, stream);
    if (e != hipSuccess) fprintf(stderr, "cooperative launch failed: %s (grid %d)\n", hipGetErrorString(e), grid_blocks);
#endif
}
```

```cpp
#include <hip/hip_runtime.h>
#include <hip/hip_cooperative_groups.h>
#include <cstdio>
namespace cg = cooperative_groups;

#define LAS __attribute__((address_space(3)))
typedef unsigned short bf16_t;
typedef short bf16x8 __attribute__((ext_vector_type(8)));
typedef float f32x4 __attribute__((ext_vector_type(4)));
typedef float f32x2 __attribute__((ext_vector_type(2)));
typedef unsigned u32x4 __attribute__((ext_vector_type(4)));
typedef unsigned u32x2 __attribute__((ext_vector_type(2)));

constexpr int MP = 16384, MS = 512, M = MP + MS, D = 1024, FF = 2816, NIN = 6400, WIN_LD = 6160, ZLD = 3072;
constexpr float EPS = 1e-6f;
constexpr int NPH = 12;
constexpr size_t MiB = (size_t)1 << 20;
constexpr size_t OFF_WFFN = 1 * MiB;
constexpr size_t SZ_W1T = (size_t)5632 * 1024 * 2;
constexpr size_t OFF_AT = OFF_WFFN;
constexpr size_t OFF_DECL = OFF_AT + (size_t)1024 * 4096 * 2;
constexpr size_t OFF_GKLR = OFF_DECL + (size_t)1024 * 128 * 4;
constexpr size_t OFF_OSS = OFF_GKLR + (size_t)M * 16 * 4;
static_assert(OFF_OSS + (size_t)M * 64 * 4 <= OFF_WFFN + (size_t)3 * 1024 * 2816 * 2, "overlay fits");
constexpr size_t OFF_WIN = 18 * MiB;
constexpr size_t OFF_WPT = OFF_WIN + (size_t)NIN * 1024 * 2;
constexpr size_t OFF_WOUT = OFF_WPT + (size_t)1024 * 256 * 2;
constexpr size_t OFF_WPG = OFF_WOUT + (size_t)1024 * 1024 * 2;
constexpr size_t OFF_WPP = OFF_WPG + (size_t)1024 * 1024 * 2;
static_assert(OFF_WPP + (size_t)1024 * 256 * 2 <= 36 * MiB, "w rest");
constexpr size_t OFF_HB = 36 * MiB;
constexpr size_t OFF_BIG = 69 * MiB;
constexpr size_t OFF_SGA = 168 * MiB;
constexpr size_t OFF_P = 201 * MiB;
constexpr size_t OFF_PB = 234 * MiB;
constexpr size_t OFF_SSA = 243 * MiB;
constexpr size_t OFF_SSB = 245 * MiB;
constexpr size_t WS_END = 247 * MiB;
constexpr size_t OUT_NPP = (size_t)M * 1024;
constexpr size_t OUT_NGP = OUT_NPP + (size_t)8 * 15 * 1024;
constexpr size_t OUT_NPS = OUT_NGP + (size_t)8 * 4 * 128 * 256;
constexpr size_t OUT_NGS = OUT_NPS + (size_t)128 * 15 * 1024;
constexpr int LDS_BYTES = 147456;

typedef __bf16 bf16v2_t __attribute__((ext_vector_type(2)));
__device__ __forceinline__ unsigned cvt_pk_bf16(float lo, float hi) { bf16v2_t v; v[0] = (__bf16)lo; v[1] = (__bf16)hi; return __builtin_bit_cast(unsigned, v); }
__device__ __forceinline__ float bf_lo(unsigned w) { return __uint_as_float(w << 16); }
__device__ __forceinline__ float bf_hi(unsigned w) { return __uint_as_float(w & 0xffff0000u); }
__device__ __forceinline__ float bf1(bf16_t b) { return __uint_as_float(((unsigned)b) << 16); }
__device__ __forceinline__ bf16_t f2bf(float f) { return (bf16_t)(cvt_pk_bf16(f, 0.f) & 0xffffu); }
__device__ __forceinline__ u32x2 pack4(f32x4 v) { u32x2 w; w.x = cvt_pk_bf16(v[0], v[1]); w.y = cvt_pk_bf16(v[2], v[3]); return w; }
__device__ __forceinline__ u32x4 pack8(f32x4 a, f32x4 b) { u32x4 w; w.x = cvt_pk_bf16(a[0], a[1]); w.y = cvt_pk_bf16(a[2], a[3]); w.z = cvt_pk_bf16(b[0], b[1]); w.w = cvt_pk_bf16(b[2], b[3]); return w; }
__device__ __forceinline__ f32x4 unpack_lo(u32x4 w) { return (f32x4){bf_lo(w.x), bf_hi(w.x), bf_lo(w.y), bf_hi(w.y)}; }
__device__ __forceinline__ f32x4 unpack_hi(u32x4 w) { return (f32x4){bf_lo(w.z), bf_hi(w.z), bf_lo(w.w), bf_hi(w.w)}; }
__device__ __forceinline__ f32x4 unpack4(u32x2 w) { return (f32x4){bf_lo(w.x), bf_hi(w.x), bf_lo(w.y), bf_hi(w.y)}; }
__device__ __forceinline__ float sigmoidf_(float x) { return __builtin_amdgcn_rcpf(1.0f + __builtin_amdgcn_exp2f(-1.4426950409f * x)); }
__device__ __forceinline__ f32x4 sigmoid4(f32x4 x) { return (f32x4){sigmoidf_(x[0]), sigmoidf_(x[1]), sigmoidf_(x[2]), sigmoidf_(x[3])}; }
__device__ __forceinline__ float sum16(const float* p) { const f32x4* q = (const f32x4*)p; const f32x4 a = q[0], b = q[1], c = q[2], d = q[3];
    return ((a[0] + a[1]) + (a[2] + a[3])) + ((b[0] + b[1]) + (b[2] + b[3])) + ((c[0] + c[1]) + (c[2] + c[3])) + ((d[0] + d[1]) + (d[2] + d[3])); }
__device__ __forceinline__ float rowscale(const float* ss, int row, float invn) { return 1.0f / sqrtf(sum16(ss + (size_t)row * 16) * invn + EPS); }
__device__ __forceinline__ float wave_sum(float v) {
#pragma unroll
    for (int o = 1; o < 64; o <<= 1) v += __shfl_xor(v, o);
    return v; }

namespace pg8 {
constexpr int BM = 256, BK = 64, HALF = 128, HTB = HALF * BK * 2, NXCD = 8, WGM = 4;
__device__ __forceinline__ int lds_byte(int r, int c) { const int st = (r >> 4) * 2 + (c >> 5), rr = r & 15, cc = c & 31, ob = rr * 64 + cc * 2; return st * 1024 + (ob ^ (((ob >> 9) & 1) << 5)); }
__device__ __forceinline__ void stage_rc(int b, int& R, int& C) { const int st = b / 1024, sb = b % 1024, swz = sb ^ (((sb >> 9) & 1) << 5); R = (st >> 1) * 16 + swz / 64; C = (st & 1) * 32 + (swz % 64) / 2; }
struct Unit { int pm, pn; };
struct Gemm { const bf16_t* A; const bf16_t* Bt; int K, lda, ldb, a_pn_off; };
struct StaticOrder {
    int nM, nN, nwg, G, c;
    __device__ void init(int M_, int N_, int G_, int c_) { nM = M_ / BM; nN = N_ / BM; nwg = nM * nN; G = G_; c = c_; }
    __device__ bool next(int i, Unit& u) const {
        const long L = (long)i * G + c; if (L >= nwg) return false;
        int wgid = (int)L; { const int q = nwg / NXCD, r = nwg % NXCD, xcd = wgid % NXCD, off = wgid / NXCD; wgid = (xcd < r ? xcd * (q + 1) : r * (q + 1) + (xcd - r) * q) + off; }
        const int nig = WGM * nN, gid = wgid / nig, fm = gid * WGM, gsz = (nM - fm) < WGM ? (nM - fm) : WGM;
        u.pm = fm + ((wgid % nig) % gsz); u.pn = (wgid % nig) / gsz; return true;
    }
};
template <class Epi>
__device__ __forceinline__ void gemm_phase(LAS unsigned char* lds, const Gemm g, const StaticOrder& S, const Epi& E) {
    const int tid = threadIdx.x, wid = __builtin_amdgcn_readfirstlane(tid >> 6), lane = tid & 63, wr = wid >> 2, wc = wid & 3, fr = lane & 15, fq = lane >> 4;
    int K_ = g.K; asm volatile("" : "+s"(K_));
    const int K = K_, nt = K / BK;
    unsigned voffA[2], voffB[2];
#pragma unroll
    for (int i = 0; i < 2; ++i) { int R, C; stage_rc(tid * 16 + i * 8192, R, C); voffA[i] = (unsigned)(R * g.lda + C) * 2u; voffB[i] = (unsigned)(R * g.ldb + C) * 2u; }
    const size_t kstep = (size_t)(BK * 2);
    const size_t hsA = (size_t)HALF * g.lda * 2, hsB = (size_t)HALF * g.ldb * 2, tsA = 2 * hsA, tsB = 2 * hsB;
    const unsigned ldsw = (unsigned)wid * 1024u;
    const int aoff = lds_byte(wr * 64 + fr, fq * 8), boff = lds_byte(wc * 32 + fr, fq * 8);
#define PG8_SA(b, h) (((b) * 2 + (h)) * HTB)
#define PG8_SB(b, h) ((4 + (b) * 2 + (h)) * HTB)
#define PG8_STAGE(bufoff, gbase, voff) do { _Pragma("unroll") for (int _i = 0; _i < 2; ++_i) \
        __builtin_amdgcn_global_load_lds((const unsigned*)((const char*)(gbase) + (voff)[_i]), (LAS unsigned*)(lds + (bufoff) + ldsw + _i * 8192), 16, 0, 0); } while (0)
#define PG8_LDA(dst, b, h) do { _Pragma("unroll") for (int m = 0; m < 4; ++m) _Pragma("unroll") for (int k = 0; k < 2; ++k) dst[m][k] = *(const LAS bf16x8*)(lds + PG8_SA(b, h) + aoff + m * 2048 + k * 1024); } while (0)
#define PG8_LDB(dst, b, h) do { _Pragma("unroll") for (int n = 0; n < 2; ++n) _Pragma("unroll") for (int k = 0; k < 2; ++k) dst[n][k] = *(const LAS bf16x8*)(lds + PG8_SB(b, h) + boff + n * 2048 + k * 1024); } while (0)
#define PG8_MMA(ai, bj, At, Bt) do { __builtin_amdgcn_s_setprio(1); _Pragma("unroll") for (int m = 0; m < 4; ++m) _Pragma("unroll") for (int n = 0; n < 2; ++n) _Pragma("unroll") for (int k = 0; k < 2; ++k) \
        acc[ai][bj][m][n] = __builtin_amdgcn_mfma_f32_16x16x32_bf16(Bt[n][k], At[m][k], acc[ai][bj][m][n], 0, 0, 0); __builtin_amdgcn_s_setprio(0); } while (0)
#define PG8_WAIT_V(n) asm volatile("s_waitcnt vmcnt(" #n ")" ::: "memory")
#define PG8_WAIT_L(n) asm volatile("s_waitcnt lgkmcnt(" #n ")" ::: "memory")
#define PG8_BAR __builtin_amdgcn_s_barrier()
#define PG8_SCHED __builtin_amdgcn_sched_barrier(0)
    Unit cur, nxt; int ui = 0;
    if (!S.next(0, cur)) return;
    f32x4 acc[2][2][4][2];
#pragma unroll
    for (int a = 0; a < 2; ++a)
#pragma unroll
        for (int b = 0; b < 2; ++b)
#pragma unroll
            for (int m = 0; m < 4; ++m)
#pragma unroll
                for (int n = 0; n < 2; ++n) acc[a][b][m][n] = (f32x4){0.f, 0.f, 0.f, 0.f};
    bf16x8 At[4][2], B0[2][2], B1[2][2];
    const char* cA = (const char*)g.A + (size_t)cur.pm * tsA + (size_t)cur.pn * g.a_pn_off; const char* cB = (const char*)g.Bt + (size_t)cur.pn * tsB;
    PG8_STAGE(PG8_SB(0, 0), cB, voffB); PG8_STAGE(PG8_SA(0, 0), cA, voffA); PG8_STAGE(PG8_SB(0, 1), cB + hsB, voffB); PG8_STAGE(PG8_SA(0, 1), cA + hsA, voffA);
    if (wr == 1) PG8_BAR;
    PG8_WAIT_V(4); PG8_BAR;
    PG8_STAGE(PG8_SB(1, 0), cB + kstep, voffB); PG8_STAGE(PG8_SA(1, 0), cA + kstep, voffA); PG8_STAGE(PG8_SB(1, 1), cB + hsB + kstep, voffB);
    PG8_WAIT_V(6); PG8_BAR;
    for (;;) {
        const bool has_next = S.next(ui + 1, nxt);
        const char* nA = has_next ? (const char*)g.A + (size_t)nxt.pm * tsA + (size_t)nxt.pn * g.a_pn_off : cA; const char* nB = has_next ? (const char*)g.Bt + (size_t)nxt.pn * tsB : cB;
#pragma unroll 1
        for (int t = 0; t < nt; t += 2) {
            const bool last = (t == nt - 2);
            const char* a1 = cA + (size_t)(t + 1) * kstep;
            const char* a2 = last ? nA : cA + (size_t)(t + 2) * kstep; const char* b2 = last ? nB : cB + (size_t)(t + 2) * kstep;
            const char* a3 = a2 + kstep; const char* b3 = b2 + kstep;
            PG8_LDB(B0, 0, 0); PG8_SCHED; PG8_LDA(At, 0, 0); PG8_STAGE(PG8_SA(1, 1), a1 + hsA, voffA);
            PG8_WAIT_L(8); PG8_BAR; PG8_WAIT_L(0); PG8_MMA(0, 0, At, B0); PG8_BAR; PG8_SCHED;
            PG8_LDB(B1, 0, 1); PG8_STAGE(PG8_SB(0, 0), b2, voffB);
            PG8_BAR; PG8_WAIT_L(0); PG8_MMA(0, 1, At, B1); PG8_BAR;
            PG8_LDA(At, 0, 1); PG8_STAGE(PG8_SA(0, 0), a2, voffA);
            PG8_BAR; PG8_WAIT_L(0); PG8_MMA(1, 0, At, B0); PG8_BAR; PG8_SCHED;
            PG8_STAGE(PG8_SB(0, 1), b2 + hsB, voffB);
            PG8_WAIT_V(6); PG8_BAR; PG8_MMA(1, 1, At, B1); PG8_BAR;
            PG8_LDB(B0, 1, 0); PG8_SCHED; PG8_LDA(At, 1, 0); PG8_STAGE(PG8_SA(0, 1), a2 + hsA, voffA);
            PG8_WAIT_L(8); PG8_BAR; PG8_WAIT_L(0); PG8_MMA(0, 0, At, B0); PG8_BAR; PG8_SCHED;
            PG8_LDB(B1, 1, 1); PG8_STAGE(PG8_SB(1, 0), b3, voffB);
            PG8_BAR; PG8_WAIT_L(0); PG8_MMA(0, 1, At, B1); PG8_BAR;
            PG8_LDA(At, 1, 1); PG8_STAGE(PG8_SA(1, 0), a3, voffA);
            PG8_BAR; PG8_WAIT_L(0); PG8_MMA(1, 0, At, B0); PG8_BAR; PG8_SCHED;
            PG8_STAGE(PG8_SB(1, 1), b3 + hsB, voffB);
            PG8_WAIT_V(6); PG8_BAR; PG8_MMA(1, 1, At, B1); PG8_BAR;
        }
        E(acc, cur, ui, wr, wc, fr, fq);
        if (!has_next) break;
#pragma unroll
        for (int a = 0; a < 2; ++a)
#pragma unroll
            for (int b = 0; b < 2; ++b)
#pragma unroll
                for (int m = 0; m < 4; ++m)
#pragma unroll
                    for (int n = 0; n < 2; ++n) acc[a][b][m][n] = (f32x4){0.f, 0.f, 0.f, 0.f};
        cur = nxt; cA = nA; cB = nB; ++ui;
    }
    PG8_WAIT_V(0);
    if (wr == 0) PG8_BAR;
    PG8_BAR;
#undef PG8_SA
#undef PG8_SB
#undef PG8_STAGE
#undef PG8_LDA
#undef PG8_LDB
#undef PG8_MMA
#undef PG8_WAIT_V
#undef PG8_WAIT_L
#undef PG8_BAR
#undef PG8_SCHED
}
}
using pg8::Unit;
typedef const f32x4 (&AccRef)[2][2][4][2];
constexpr int RS_OFF = 131072;
__device__ __forceinline__ void fill_rs(LAS unsigned char* lds, const pg8::StaticOrder& S, const float* ss) {
    LAS float* tab = (LAS float*)(lds + RS_OFF); Unit u; const int wave = threadIdx.x >> 6, lane = threadIdx.x & 63;
    if (S.next(wave, u)) { float v[4];
#pragma unroll
        for (int k = 0; k < 4; ++k) v[k] = sum16(ss + (size_t)(u.pm * 256 + lane + 64 * k) * 16);
#pragma unroll
        for (int k = 0; k < 4; ++k) tab[wave * 256 + lane + 64 * k] = 1.0f / sqrtf(v[k] * (1.0f / 1024.0f) + EPS); }
    __syncthreads();
}
__device__ __forceinline__ void fill_rso(LAS unsigned char* lds, const pg8::StaticOrder& S, const float* oss) {
    LAS float* tab = (LAS float*)(lds + RS_OFF); Unit u; const int wave = threadIdx.x >> 6, lane = threadIdx.x & 63;
    if (S.next(wave, u)) { float v[4];
#pragma unroll
        for (int k = 0; k < 4; ++k) v[k] = sum16(oss + (size_t)(u.pm * 256 + lane + 64 * k) * 64 + u.pn * 16);
#pragma unroll
        for (int k = 0; k < 4; ++k) tab[wave * 256 + lane + 64 * k] = 1.0f / sqrtf(v[k] * (1.0f / 256.0f) + EPS); }
    __syncthreads();
}
struct EpiSwiglu { bf16_t* act; const LAS float* rs_tab;
    __device__ __forceinline__ void operator()(AccRef acc, const Unit& u, int ui, int wr, int wc, int fr, int fq) const {
        const int rl0 = wr * 64 + fr; const LAS float* tab = rs_tab + ui * 256 + rl0;
        bf16_t* base = act + (size_t)(u.pm * 256 + rl0) * FF + u.pn * 128 + wc * 32 + fq * 8;
#pragma unroll
        for (int ai = 0; ai < 2; ++ai)
#pragma unroll
            for (int m = 0; m < 4; ++m) { const int rl = ai * 128 + m * 16; const float rs = tab[rl]; f32x4 o[2];
#pragma unroll
                for (int bj = 0; bj < 2; ++bj) { const f32x4 gt = acc[ai][bj][m][0] * rs, up = acc[ai][bj][m][1] * rs; o[bj] = gt * sigmoid4(gt) * up; }
                *(u32x4*)(base + (size_t)rl * FF) = pack8(o[0], o[1]); }
    } };
struct EpiResid { bf16_t* hb; float* ssw; float scale;
    __device__ __forceinline__ void operator()(AccRef acc, const Unit& u, int ui, int wr, int wc, int fr, int fq) const {
        const int row0 = u.pm * 256 + wr * 64 + fr, col0 = u.pn * 256 + wc * 32 + fq * 8;
        bf16_t* hbase = hb + (size_t)row0 * 1024 + col0; float* sbase = ssw + (size_t)row0 * 16 + u.pn * 4 + wc;
        u32x4 r[8][2];
#pragma unroll
        for (int g = 0; g < 8; ++g) { const int rl = (g >> 2) * 128 + (g & 3) * 16;
#pragma unroll
            for (int bj = 0; bj < 2; ++bj) r[g][bj] = *(const u32x4*)(hbase + (size_t)rl * 1024 + bj * 128); }
#pragma unroll
        for (int g = 0; g < 8; ++g) { const int ai = g >> 2, m = g & 3, rl = ai * 128 + m * 16; float sq = 0.f;
#pragma unroll
            for (int bj = 0; bj < 2; ++bj) { const f32x4 v0 = unpack_lo(r[g][bj]) + acc[ai][bj][m][0] * scale, v1 = unpack_hi(r[g][bj]) + acc[ai][bj][m][1] * scale;
                *(u32x4*)(hbase + (size_t)rl * 1024 + bj * 128) = pack8(v0, v1);
                sq += ((v0[0] * v0[0] + v0[1] * v0[1]) + (v0[2] * v0[2] + v0[3] * v0[3])) + ((v1[0] * v1[0] + v1[1] * v1[1]) + (v1[2] * v1[2] + v1[3] * v1[3])); }
            sq += __shfl_xor(sq, 16); sq += __shfl_xor(sq, 32);
            if (fq == 0) sbase[(size_t)rl * 16] = sq; }
    } };
struct EpiZ { bf16_t* zA; bf16_t* sga; bf16_t* P; float* gklr; const LAS float* rs_tab; const float* gnorm;
    __device__ __forceinline__ void operator()(AccRef acc, const Unit& u, int ui, int wr, int wc, int fr, int fq) const {
        const int rl0 = wr * 64 + fr, row0 = u.pm * 256 + rl0; const int pn = u.pn; const LAS float* tab = rs_tab + ui * 256 + rl0;
        if (pn < 12) { bf16_t* base = zA + (size_t)row0 * ZLD + pn * 256 + wc * 32 + fq * 8;
#pragma unroll
            for (int ai = 0; ai < 2; ++ai)
#pragma unroll
                for (int m = 0; m < 4; ++m) { const int rl = ai * 128 + m * 16; const float rs = tab[rl];
#pragma unroll
                    for (int bj = 0; bj < 2; ++bj) *(u32x4*)(base + (size_t)rl * ZLD + bj * 128) = pack8(acc[ai][bj][m][0] * rs, acc[ai][bj][m][1] * rs); }
        } else if (pn < 16) { bf16_t* base = sga + (size_t)row0 * 1024 + (pn - 12) * 256 + wc * 32 + fq * 8;
#pragma unroll
            for (int ai = 0; ai < 2; ++ai)
#pragma unroll
                for (int m = 0; m < 4; ++m) { const int rl = ai * 128 + m * 16; const float rs = tab[rl];
#pragma unroll
                    for (int bj = 0; bj < 2; ++bj) *(u32x4*)(base + (size_t)rl * 1024 + bj * 128) = pack8(sigmoid4(acc[ai][bj][m][0] * rs), sigmoid4(acc[ai][bj][m][1] * rs)); }
        } else if (pn < 24) { const int c0 = (pn - 16) * 128 + wc * 32 + fq * 8; bf16_t* base = P + (size_t)row0 * 1024 + c0;
            const f32x4 gn0 = *(const f32x4*)(gnorm + (c0 & 255)), gn1 = *(const f32x4*)(gnorm + ((c0 + 4) & 255));
#pragma unroll
            for (int ai = 0; ai < 2; ++ai)
#pragma unroll
                for (int m = 0; m < 4; ++m) { const int rl = ai * 128 + m * 16; const float rs = tab[rl]; f32x4 o[2];
#pragma unroll
                    for (int bj = 0; bj < 2; ++bj) { const f32x4 gv = acc[ai][bj][m][0] * rs, gb = acc[ai][bj][m][1] * rs; o[bj] = sigmoid4(gb) * gv * sigmoid4(gv) * (bj ? gn1 : gn0); }
                    *(u32x4*)(base + (size_t)rl * 1024) = pack8(o[0], o[1]); }
        } else if (wc == 0 && fq < 2) {
#pragma unroll
            for (int ai = 0; ai < 2; ++ai)
#pragma unroll
                for (int m = 0; m < 4; ++m) { const int rl = ai * 128 + m * 16; const float rs = tab[rl];
                    *(f32x4*)(gklr + (size_t)(row0 + rl) * 16 + fq * 8) = acc[ai][0][m][0] * rs; *(f32x4*)(gklr + (size_t)(row0 + rl) * 16 + fq * 8 + 4) = acc[ai][0][m][1] * rs; }
        }
    } };
struct EpiMix { bf16_t* sga; const bf16_t* P; const bf16_t* o; const LAS float* rso_tab;
    __device__ __forceinline__ void operator()(AccRef acc, const Unit& u, int ui, int wr, int wc, int fr, int fq) const {
        const int rl0 = wr * 64 + fr, row0 = u.pm * 256 + rl0; const int colb = u.pn * 256 + wc * 32 + fq * 8; const LAS float* tab = rso_tab + ui * 256 + rl0;
        bf16_t* sb = sga + (size_t)row0 * 1024 + colb; const bf16_t* pb_ = P + (size_t)row0 * 1024 + colb; const bf16_t* ob = o + (size_t)row0 * ZLD + colb;
        u32x4 ro[3][2], rsg[3][2], rp[3][2];
#define MIX_LD(slot, g_) do { const int rl_ = ((g_) >> 2) * 128 + ((g_) & 3) * 16; _Pragma("unroll") for (int bj = 0; bj < 2; ++bj) { \
            ro[slot][bj] = *(const u32x4*)(ob + (size_t)rl_ * ZLD + bj * 128); rsg[slot][bj] = *(const u32x4*)(sb + (size_t)rl_ * 1024 + bj * 128); rp[slot][bj] = *(const u32x4*)(pb_ + (size_t)rl_ * 1024 + bj * 128); } } while (0)
        MIX_LD(0, 0); MIX_LD(1, 1); MIX_LD(2, 2);
#pragma unroll
        for (int g = 0; g < 8; ++g) { const int ai = g >> 2, m = g & 3, rl = ai * 128 + m * 16; const float rso = tab[rl]; u32x4 res[2];
#pragma unroll
            for (int bj = 0; bj < 2; ++bj) res[bj] = pack8(unpack_lo(rsg[g % 3][bj]) * acc[ai][bj][m][0] + unpack_lo(rp[g % 3][bj]) * (unpack_lo(ro[g % 3][bj]) * rso),
                                                           unpack_hi(rsg[g % 3][bj]) * acc[ai][bj][m][1] + unpack_hi(rp[g % 3][bj]) * (unpack_hi(ro[g % 3][bj]) * rso));
            if (g + 3 < 8) MIX_LD(g % 3, g + 3);
#pragma unroll
            for (int bj = 0; bj < 2; ++bj) *(u32x4*)(sb + (size_t)rl * 1024 + bj * 128) = res[bj];
        }
#undef MIX_LD
    } };
struct EpiBf16 { bf16_t* out;
    __device__ __forceinline__ void operator()(AccRef acc, const Unit& u, int ui, int wr, int wc, int fr, int fq) const {
        bf16_t* base = out + (size_t)(u.pm * 256 + wr * 64 + fr) * 1024 + u.pn * 256 + wc * 32 + fq * 8;
#pragma unroll
        for (int ai = 0; ai < 2; ++ai)
#pragma unroll
            for (int m = 0; m < 4; ++m)
#pragma unroll
                for (int bj = 0; bj < 2; ++bj) *(u32x4*)(base + (size_t)(ai * 128 + m * 16) * 1024 + bj * 128) = pack8(acc[ai][bj][m][0], acc[ai][bj][m][1]);
    } };
struct EpiPle { float* h; const bf16_t* hb; const bf16_t* pp; const LAS float* rs_tab; float* ssw;
    __device__ __forceinline__ void operator()(AccRef acc, const Unit& u, int ui, int wr, int wc, int fr, int fq) const {
        const int rl0 = wr * 64 + fr, row0 = u.pm * 256 + rl0, col0 = u.pn * 256 + wc * 32 + fq * 8; const LAS float* tab = rs_tab + ui * 256 + rl0;
        float* obase = h + (size_t)row0 * 1024 + col0; const bf16_t* hbase = hb + (size_t)row0 * 1024 + col0; const bf16_t* pbase = pp + (size_t)row0 * 1024 + col0; float* sbase = ssw + (size_t)row0 * 16 + u.pn * 4 + wc;
        u32x4 rh[4][2], rp[4][2];
#define PLE_LD(slot, g_) do { const int rl_ = ((g_) >> 2) * 128 + ((g_) & 3) * 16; _Pragma("unroll") for (int bj = 0; bj < 2; ++bj) { \
            rh[slot][bj] = *(const u32x4*)(hbase + (size_t)rl_ * 1024 + bj * 128); rp[slot][bj] = *(const u32x4*)(pbase + (size_t)rl_ * 1024 + bj * 128); } } while (0)
        PLE_LD(0, 0); PLE_LD(1, 1); PLE_LD(2, 2); PLE_LD(3, 3);
#pragma unroll
        for (int g = 0; g < 8; ++g) { const int ai = g >> 2, m = g & 3, rl = ai * 128 + m * 16; const float rs = tab[rl]; float sq = 0.f; f32x4 res[2][2];
#pragma unroll
            for (int bj = 0; bj < 2; ++bj) { const f32x4 v0 = unpack_lo(rh[g & 3][bj]) + sigmoid4(acc[ai][bj][m][0] * rs) * unpack_lo(rp[g & 3][bj]), v1 = unpack_hi(rh[g & 3][bj]) + sigmoid4(acc[ai][bj][m][1] * rs) * unpack_hi(rp[g & 3][bj]);
                res[bj][0] = v0; res[bj][1] = v1; sq += ((v0[0] * v0[0] + v0[1] * v0[1]) + (v0[2] * v0[2] + v0[3] * v0[3])) + ((v1[0] * v1[0] + v1[1] * v1[1]) + (v1[2] * v1[2] + v1[3] * v1[3])); }
            if (g + 4 < 8) PLE_LD(g & 3, g + 4);
#pragma unroll
            for (int bj = 0; bj < 2; ++bj) { *(f32x4*)(obase + (size_t)rl * 1024 + bj * 128) = res[bj][0]; *(f32x4*)(obase + (size_t)rl * 1024 + bj * 128 + 4) = res[bj][1]; }
            sq += __shfl_xor(sq, 16); sq += __shfl_xor(sq, 32);
            if (fq == 0) sbase[(size_t)rl * 16] = sq; }
#undef PLE_LD
    } };

struct Params { const float* in[26]; float* out; unsigned char* ws; int ph_lo, ph_hi; };

template <int MODE>
__device__ __forceinline__ void tr_item(const float* src0, const float* src1, int ldsrc, int K, bf16_t* dst, const float* gain, LAS float* scr, int item, int nblk, int lane, const float* cs = nullptr) {
    const int kb = item / nblk, nb = item % nblk, k0 = 64 * kb, n0 = 32 * nb;
    const int r8 = lane >> 3, c4 = (lane & 7) * 4; const float* sp; f32x4 sc = (f32x4){1.f, 1.f, 1.f, 1.f};
    const int lc = 8 * ((c4 >> 2) & 3) + 4 * (c4 >> 4);
    const int gq = (n0 & 255) >> 5, fi = (n0 >> 8) * 128 + (gq & 3) * 32 + ((c4 >> 2) & 3) * 8 + (gq >> 2) * 4;
    if (MODE == 0) { sp = src0 + n0 + lc; if (cs) sc = *(const f32x4*)(cs + n0 + lc); }
    else if (MODE == 1) { sp = ((c4 >> 4) ? src1 : src0) + fi; }
    else { const int n = n0 + lc;
           if (n0 < 3072) { sp = src0 + n; if (n0 >= 1024 && n0 < 1536) sc = sc * 0.08838834764831845f; }
           else if (n0 < 4096) sp = src0 + 4112 + (n - 3072);
           else if (n0 < 6144) sp = src0 + ((c4 >> 4) ? 5136 : 3088) + (fi - 2048);
           else if (n0 == 6144 && lc < 16) sp = src0 + 3072 + lc;
           else sp = nullptr; }
    f32x4 v[8];
#pragma unroll
    for (int i = 0; i < 8; ++i) { const int kk = 8 * i + r8; v[i] = sp ? __builtin_nontemporal_load((const f32x4*)(sp + (size_t)(k0 + kk) * ldsrc)) : (f32x4){0.f, 0.f, 0.f, 0.f}; }
#pragma unroll
    for (int i = 0; i < 8; ++i) { const int kk = 8 * i + r8; f32x4 t = v[i] * sc; if (gain) t = t * gain[k0 + kk];
        scr[kk * 33 + c4] = t[0]; scr[kk * 33 + c4 + 1] = t[1]; scr[kk * 33 + c4 + 2] = t[2]; scr[kk * 33 + c4 + 3] = t[3]; }
    asm volatile("s_waitcnt lgkmcnt(0)" ::: "memory");
    const int c = lane & 7;
#pragma unroll
    for (int j = 0; j < 4; ++j) { const int nn = (lane >> 3) + 8 * j; const LAS float* s_ = scr + (8 * c) * 33 + nn;
        u32x4 o; o.x = cvt_pk_bf16(s_[0 * 33], s_[1 * 33]); o.y = cvt_pk_bf16(s_[2 * 33], s_[3 * 33]); o.z = cvt_pk_bf16(s_[4 * 33], s_[5 * 33]); o.w = cvt_pk_bf16(s_[6 * 33], s_[7 * 33]);
        *(u32x4*)(dst + (size_t)(n0 + nn) * K + k0 + 8 * c) = o; }
    asm volatile("s_waitcnt lgkmcnt(0)" ::: "memory");
}
__device__ __forceinline__ void conv_ffn(const Params& p, int base, bf16_t* w1t, LAS float* scr, int gw, int NGW, int lane, int part = 0) {
    bf16_t* w2t = w1t + SZ_W1T / 2;
    constexpr int I1 = 16 * 176, I2 = 44 * 32;
    const int lo_ = (part == 2) ? I1 : 0, hi_ = (part == 1) ? I1 : I1 + I2;
    for (int it = lo_ + gw; it < hi_; it += NGW) {
        if (it < I1) tr_item<1>(p.in[base + 1], p.in[base + 2], FF, 1024, w1t, p.in[base], scr, it, 176, lane);
        else tr_item<0>(p.in[base + 3], nullptr, 1024, FF, w2t, nullptr, scr, it - I1, 32, lane);
    }
}
constexpr size_t Y_FFN2_OFF = (size_t)33 * MiB;
__device__ __forceinline__ void conv_rest(const Params& p, LAS unsigned char* lds, int gw, int NGW) {
    const int tid = threadIdx.x, lane = tid & 63, wave = tid >> 6; LAS float* scr = (LAS float*)(lds + wave * 16384); unsigned char* ws = p.ws;
    constexpr int I_IN = 16 * 200, I_POOL = 4 * 4 * 8, I_OUT = 16 * 32, I_PG = 16 * 32, I_PP = 4 * 32;
    for (int it = gw; it < I_IN + I_POOL + I_OUT + I_PG + I_PP; it += NGW) {
        int r = it;
        if (r < I_IN) { tr_item<2>(p.in[11], nullptr, WIN_LD, 1024, (bf16_t*)(ws + OFF_WIN), p.in[10], scr, r, 200, lane); continue; } r -= I_IN;
        if (r < I_POOL) { const int g = r >> 5; tr_item<0>(p.in[15] + (size_t)g * 65536, nullptr, 256, 256, (bf16_t*)(ws + OFF_WPT) + (size_t)g * 65536, nullptr, scr, r & 31, 8, lane, p.in[16] + g * 256); continue; } r -= I_POOL;
        if (r < I_OUT) { tr_item<0>(p.in[17], nullptr, 1024, 1024, (bf16_t*)(ws + OFF_WOUT), nullptr, scr, r, 32, lane); continue; } r -= I_OUT;
        if (r < I_PG) { tr_item<0>(p.in[23], nullptr, 1024, 1024, (bf16_t*)(ws + OFF_WPG), p.in[22], scr, r, 32, lane); continue; } r -= I_PG;
        tr_item<0>(p.in[24], nullptr, 1024, 256, (bf16_t*)(ws + OFF_WPP), nullptr, scr, r, 32, lane);
    }
}
__device__ __forceinline__ void phase_prep(const Params& p, LAS unsigned char* lds) {
    const int tid = threadIdx.x, lane = tid & 63, wave = tid >> 6; const int gw = blockIdx.x * 8 + wave, NGW = gridDim.x * 8;
    LAS float* scr = (LAS float*)(lds + wave * 16384);
    unsigned char* ws = p.ws;
    conv_ffn(p, 6, (bf16_t*)(ws + OFF_WFFN), scr, gw, NGW, lane);
    bf16_t* xb = (bf16_t*)(ws + OFF_HB); float* ssa = (float*)(ws + OFF_SSA); bf16_t* pb = (bf16_t*)(ws + OFF_PB);
    for (int row0 = gw; row0 < M; row0 += 2 * NGW) {
        f32x4 v[2][4], pv[2]; float sx[2];
#pragma unroll
        for (int e = 0; e < 2; ++e) { const int row = row0 + e * NGW; if (row < M) {
            const float* xr = (row < MP) ? p.in[0] + (size_t)row * 1024 : p.in[1] + (size_t)(row - MP) * 1024;
            const float* pr = (row < MP) ? p.in[2] + (size_t)row * 256 : p.in[3] + (size_t)(row - MP) * 256;
#pragma unroll
            for (int j = 0; j < 4; ++j) v[e][j] = __builtin_nontemporal_load((const f32x4*)(xr + j * 256 + lane * 4));
            pv[e] = __builtin_nontemporal_load((const f32x4*)(pr + lane * 4)); } }
#pragma unroll
        for (int e = 0; e < 2; ++e) { const int row = row0 + e * NGW; if (row < M) { float s_ = 0.f;
#pragma unroll
            for (int j = 0; j < 4; ++j) s_ += (v[e][j][0] * v[e][j][0] + v[e][j][1] * v[e][j][1]) + (v[e][j][2] * v[e][j][2] + v[e][j][3] * v[e][j][3]);
            sx[e] = wave_sum(s_);
#pragma unroll
            for (int j = 0; j < 4; ++j) *(u32x2*)(xb + (size_t)row * 1024 + j * 256 + lane * 4) = pack4(v[e][j]);
            if (lane < 16) ssa[(size_t)row * 16 + lane] = (lane == 0) ? sx[e] : 0.f;
            *(u32x2*)(pb + (size_t)row * 256 + lane * 4) = pack4(pv[e]); } }
    }
}

__device__ __forceinline__ float logsig16(float x) { return (fminf(x, 0.f) - __logf(1.0f + __expf(-fabsf(x)))) * 0.0625f; }
struct PrepPf { f32x4 gk; u32x4 v[4], q[2], k[2]; };
__device__ __forceinline__ void prep_prefetch(const Params& p, int item, PrepPf& pf) {
    const bf16_t* zA = (const bf16_t*)(p.ws + OFF_BIG); const float* gklr = (const float*)(p.ws + OFF_GKLR);
    const int b = item >> 7, n = (item >> 2) & 31, h = item & 3, r0 = b * 2048 + n * 64, tid = threadIdx.x;
    pf.gk = (f32x4){0.f, 0.f, 0.f, 0.f};
    if (tid < 256) pf.gk = *(const f32x4*)(gklr + (size_t)r0 * 16 + tid * 4);
#pragma unroll
    for (int x = 0; x < 4; ++x) { const int q = tid + 512 * x, row = q >> 5, cc = q & 31; pf.v[x] = *(const u32x4*)(zA + (size_t)(r0 + row) * ZLD + 2048 + h * 256 + cc * 8); }
#pragma unroll
    for (int x = 0; x < 2; ++x) { const int q = tid + 512 * x, row = q >> 4, cc = q & 15;
        pf.q[x] = *(const u32x4*)(zA + (size_t)(r0 + row) * ZLD + 1024 + h * 128 + cc * 8); pf.k[x] = *(const u32x4*)(zA + (size_t)(r0 + row) * ZLD + 1536 + h * 128 + cc * 8); }
}
__device__ __forceinline__ void gla_prep_item(const Params& p, LAS unsigned char* lds, int item, PrepPf& pf, int next_item) {
    unsigned char* ws = p.ws; bf16_t* zA = (bf16_t*)(ws + OFF_BIG);
    bf16_t* At = (bf16_t*)(ws + OFF_AT); float* decl = (float*)(ws + OFF_DECL);
    const int b = item >> 7, n = (item >> 2) & 31, h = item & 3, r0 = b * 2048 + n * 64;
    const int tid = threadIdx.x, cch = tid & 127, jq = tid >> 7, lane = tid & 63, wave = tid >> 6, fr = lane & 15, fq = lane >> 4;
    LAS float* gk_l = (LAS float*)lds; LAS float* tot = (LAS float*)(lds + 4096);
    LAS bf16_t* QL = (LAS bf16_t*)(lds + 6144); LAS bf16_t* KL = (LAS bf16_t*)(lds + 23552); LAS bf16_t* VL = (LAS bf16_t*)(lds + 40960);
    if (tid < 256) *(LAS f32x4*)(gk_l + tid * 4) = pf.gk;
#pragma unroll
    for (int x = 0; x < 4; ++x) { const int q = tid + 512 * x, row = q >> 5, cc = q & 31; *(LAS u32x4*)(VL + row * 264 + cc * 8) = pf.v[x]; }
#pragma unroll
    for (int x = 0; x < 2; ++x) { const int q = tid + 512 * x, row = q >> 4, cc = q & 15; *(LAS u32x4*)(QL + row * 136 + cc * 8) = pf.q[x]; *(LAS u32x4*)(KL + row * 136 + cc * 8) = pf.k[x]; }
    float bl[16]; float run = 0.f;
    { float wup[16];
#pragma unroll
      for (int i = 0; i < 16; ++i) wup[i] = p.in[12][i * 512 + h * 128 + cch];
      const float bg = p.in[13][h * 128 + cch];
      asm volatile("s_waitcnt vmcnt(0) lgkmcnt(0)" ::: "memory");
      __syncthreads();
#pragma unroll
      for (int i = 0; i < 16; ++i) { const int j = jq * 16 + i; float x = bg;
#pragma unroll
        for (int r = 0; r < 16; ++r) x += gk_l[j * 16 + r] * wup[r];
        run += logsig16(x); bl[i] = run; } }
    tot[jq * 128 + cch] = run;
    __syncthreads();
    float pre = 0.f, blast = 0.f;
#pragma unroll
    for (int q = 0; q < 4; ++q) { const float t = tot[q * 128 + cch]; blast += t; if (q < jq) pre += t; }
    unsigned kd[8];
#pragma unroll
    for (int i = 0; i < 16; i += 2) { float kdv[2];
#pragma unroll
        for (int e = 0; e < 2; ++e) { const int ii = i + e, j = jq * 16 + ii; const float bb = bl[ii] + pre; const float qraw = bf1(QL[j * 136 + cch]), kraw = bf1(KL[j * 136 + cch]);
            const float qt = qraw * __expf(bb), kt = kraw * __expf(-bb); kdv[e] = kraw * __expf(blast - bb);
            QL[j * 136 + cch] = f2bf(qt); KL[j * 136 + cch] = f2bf(kt); }
        kd[i >> 1] = cvt_pk_bf16(kdv[0], kdv[1]); }
    if (jq == 0) decl[(size_t)item * 128 + cch] = __expf(blast);
    { bf16_t* dst = zA + (size_t)(r0 + (cch >> 1)) * ZLD + 1536 + h * 128 + (cch & 1) * 64 + jq * 16;
      *(u32x4*)dst = (u32x4){kd[0], kd[1], kd[2], kd[3]}; *(u32x4*)(dst + 8) = (u32x4){kd[4], kd[5], kd[6], kd[7]}; }
    __syncthreads();
#pragma unroll
    for (int x = 0; x < 2; ++x) { const int q = tid + 512 * x, row = q >> 4, cc = q & 15;
        *(u32x4*)(zA + (size_t)(r0 + row) * ZLD + 1024 + h * 128 + cc * 8) = *(const LAS u32x4*)(QL + row * 136 + cc * 8); }
    { const int tt = wave >> 1;
#pragma unroll
      for (int x = 0; x < 2; ++x) { const int jt = (wave & 1) * 2 + x; f32x4 a = (f32x4){0.f, 0.f, 0.f, 0.f};
        if (jt <= tt) {
#pragma unroll
            for (int ks = 0; ks < 4; ++ks) { const bf16x8 xk = *(const LAS bf16x8*)(KL + (16 * jt + fr) * 136 + 32 * ks + 8 * fq), yq = *(const LAS bf16x8*)(QL + (16 * tt + fr) * 136 + 32 * ks + 8 * fq);
                a = __builtin_amdgcn_mfma_f32_16x16x32_bf16(xk, yq, a, 0, 0, 0); } }
        const int t = 16 * tt + fr, j0 = 16 * jt + 4 * fq;
#pragma unroll
        for (int r = 0; r < 4; ++r) if (j0 + r > t) a[r] = 0.f;
        *(u32x2*)(At + (size_t)item * 4096 + t * 64 + j0) = pack4(a); } }
#pragma unroll
    for (int x = 0; x < 2; ++x) { const int pi = tid + 512 * x, vv = pi >> 2, j2 = pi & 3; unsigned w[8];
#pragma unroll
        for (int i = 0; i < 8; ++i) { const unsigned lo = VL[(j2 * 16 + 2 * i) * 264 + vv], hi = VL[(j2 * 16 + 2 * i + 1) * 264 + vv]; w[i] = lo | (hi << 16); }
        bf16_t* dst = zA + (size_t)(r0 + (vv >> 2)) * ZLD + 2048 + h * 256 + (vv & 3) * 64 + j2 * 16;
        *(u32x4*)dst = (u32x4){w[0], w[1], w[2], w[3]}; *(u32x4*)(dst + 8) = (u32x4){w[4], w[5], w[6], w[7]}; }
    if (next_item >= 0) prep_prefetch(p, next_item, pf);
    __syncthreads();
}
template <int W>
__device__ __forceinline__ void pool_tile(const bf16_t* zA, bf16_t* pooled, size_t rb, int t0, int c0) {
    unsigned prev[16], cur[16];
#pragma unroll
    for (int i = 0; i < 16; ++i) { const int tt = t0 - 16 + i; prev[i] = (tt >= 0) ? *(const unsigned*)(zA + (rb + tt) * ZLD + c0) : 0u; }
    float s0 = 0.f, s1 = 0.f;
#pragma unroll
    for (int i = 17 - W; i < 16; ++i) { s0 += bf_lo(prev[i]); s1 += bf_hi(prev[i]); }
#pragma unroll 1
    for (int blk = 0; blk < 4; ++blk) { const int tb = t0 + blk * 16;
#pragma unroll
        for (int i = 0; i < 16; ++i) cur[i] = *(const unsigned*)(zA + (rb + tb + i) * ZLD + c0);
#pragma unroll
        for (int i = 0; i < 16; ++i) { const float u0 = bf_lo(cur[i]), u1 = bf_hi(cur[i]); s0 += u0; s1 += u1; const int t = tb + i;
            const float ic = 1.0f / (float)((t + 1 < W) ? (t + 1) : W);
            *(unsigned*)(pooled + (rb + t) * 1024 + c0) = cvt_pk_bf16(s0 * ic - u0, s1 * ic - u1);
            const int k = i - W + 1; const unsigned d = (k >= 0) ? cur[k >= 0 ? k : 0] : prev[k >= 0 ? 0 : 16 + k]; s0 -= bf_lo(d); s1 -= bf_hi(d); }
#pragma unroll
        for (int i = 0; i < 16; ++i) prev[i] = cur[i]; }
}
__device__ __forceinline__ void pool_prompt_item(const Params& p, int item) {
    unsigned char* ws = p.ws; const bf16_t* zA = (const bf16_t*)(ws + OFF_BIG); bf16_t* pooled = (bf16_t*)p.out;
    const int b = item >> 5, n = item & 31, tid = threadIdx.x, c0 = 2 * tid, g = c0 >> 8, t0 = n * 64; const size_t rb = (size_t)b * 2048;
    if (g == 0) pool_tile<2>(zA, pooled, rb, t0, c0); else if (g == 1) pool_tile<4>(zA, pooled, rb, t0, c0); else if (g == 2) pool_tile<8>(zA, pooled, rb, t0, c0); else pool_tile<16>(zA, pooled, rb, t0, c0);
    if (n == 31) { float* np = p.out + OUT_NPP + (size_t)b * 15 * 1024;
#pragma unroll
        for (int i = 0; i < 15; ++i) { const unsigned v = *(const unsigned*)(zA + (rb + 2033 + i) * ZLD + c0); *(f32x2*)(np + i * 1024 + c0) = (f32x2){bf_lo(v), bf_hi(v)}; } }
}
template <int W>
__device__ __forceinline__ void pool_sample_w(const float (&e0)[19], const float (&e1)[19], bf16_t* prow, int c0) {
#pragma unroll
    for (int t = 0; t < 4; ++t) { float s0 = 0.f, s1 = 0.f;
#pragma unroll
        for (int r = 15 + t - W + 1; r <= 15 + t; ++r) { s0 += e0[r]; s1 += e1[r]; }
        *(unsigned*)(prow + (size_t)t * 1024 + c0) = cvt_pk_bf16(s0 * (1.0f / W) - e0[15 + t], s1 * (1.0f / W) - e1[15 + t]); }
}
__device__ __forceinline__ void pool_sample_item(const Params& p, int b) {
    unsigned char* ws = p.ws; const bf16_t* zA = (const bf16_t*)(ws + OFF_BIG); bf16_t* pooled = (bf16_t*)p.out;
    const int tid = threadIdx.x, c0 = 2 * tid, g = c0 >> 8; const float* sp = p.in[4] + (size_t)b * 15 * 1024; const size_t r0 = (size_t)MP + b * 4;
    float e0[19], e1[19];
#pragma unroll
    for (int r = 0; r < 15; ++r) { const f32x2 v = *(const f32x2*)(sp + r * 1024 + c0); e0[r] = v[0]; e1[r] = v[1]; }
#pragma unroll
    for (int t = 0; t < 4; ++t) { const unsigned v = *(const unsigned*)(zA + (r0 + t) * ZLD + c0); e0[15 + t] = bf_lo(v); e1[15 + t] = bf_hi(v); }
    bf16_t* prow = pooled + r0 * 1024;
    if (g == 0) pool_sample_w<2>(e0, e1, prow, c0); else if (g == 1) pool_sample_w<4>(e0, e1, prow, c0); else if (g == 2) pool_sample_w<8>(e0, e1, prow, c0); else pool_sample_w<16>(e0, e1, prow, c0);
    float* np = p.out + OUT_NPS + (size_t)b * 15 * 1024;
#pragma unroll
    for (int i = 0; i < 15; ++i) *(f32x2*)(np + i * 1024 + c0) = (f32x2){e0[i + 4], e1[i + 4]};
}

constexpr int RB_Q = 0, RB_K = 17408, RB_A = 35840, RB_V = 45056, RB_D = 63488, RB_SZ = 65536;
__device__ __forceinline__ void gla_rec_item(const Params& p, LAS unsigned char* lds, int item) {
    unsigned char* ws = p.ws; bf16_t* zA = (bf16_t*)(ws + OFF_BIG); const bf16_t* At = (const bf16_t*)(ws + OFF_AT); const float* decl = (const float*)(ws + OFF_DECL); float* oss = (float*)(ws + OFF_OSS);
    const int quarter = item & 3, h = (item >> 2) & 3, b = item >> 4;
    const int tid = threadIdx.x, lane = tid & 63, wave = tid >> 6, fr = lane & 15, fq = lane >> 4;
    f32x4 S[8];
#pragma unroll
    for (int i = 0; i < 8; ++i) S[i] = (f32x4){0.f, 0.f, 0.f, 0.f};
    u32x4 rqA[2], rkA[2], raA, rvA, rqB[2], rkB[2], raB, rvB; f32x4 rdA = (f32x4){0.f, 0.f, 0.f, 0.f}, rdB = (f32x4){0.f, 0.f, 0.f, 0.f};
#define REC_LOAD(T, nn) do { const int r0_ = b * 2048 + (nn) * 64; const size_t it_ = (size_t)((b * 32 + (nn)) * 4 + h); \
        _Pragma("unroll") for (int x = 0; x < 2; ++x) { const int id = tid + 512 * x; \
            rq##T[x] = *(const u32x4*)(zA + (size_t)(r0_ + (id >> 4)) * ZLD + 1024 + h * 128 + (id & 15) * 8); \
            rk##T[x] = *(const u32x4*)(zA + (size_t)(r0_ + (id >> 4)) * ZLD + 1536 + h * 128 + (id & 15) * 8); \
            } \
        rv##T = *(const u32x4*)(zA + (size_t)(r0_ + 16 * quarter + (tid >> 5)) * ZLD + 2048 + h * 256 + (tid & 31) * 8); \
        ra##T = *(const u32x4*)(At + it_ * 4096 + (tid >> 3) * 64 + (tid & 7) * 8); \
        if (tid < 32) rd##T = *(const f32x4*)(decl + it_ * 128 + tid * 4); } while (0)
#define REC_STORE(T, buf) do { LAS unsigned char* B_ = lds + (buf) * RB_SZ; \
        _Pragma("unroll") for (int x = 0; x < 2; ++x) { const int id = tid + 512 * x; \
            *(LAS u32x4*)(B_ + RB_Q + (id >> 4) * 272 + (id & 15) * 16) = rq##T[x]; \
            *(LAS u32x4*)(B_ + RB_K + (2 * (id >> 4) + ((id & 15) >> 3)) * 144 + (id & 7) * 16) = rk##T[x]; \
            } \
        *(LAS u32x4*)(B_ + RB_V + (4 * (tid >> 5) + ((tid & 31) >> 3)) * 144 + (tid & 7) * 16) = rv##T; \
        *(LAS u32x4*)(B_ + RB_A + (tid >> 3) * 144 + (tid & 7) * 16) = ra##T; \
        if (tid < 32) *(LAS f32x4*)(B_ + RB_D + tid * 16) = rd##T; } while (0)
#define REC_STEP(n) do { \
        const LAS unsigned char* B = lds + ((n) & 1) * RB_SZ; const int r0 = b * 2048 + (n) * 64; \
        bf16x8 vt[2]; u32x2 qf[4][4][2]; bf16x8 af[4][2]; \
        _Pragma("unroll") for (int jk = 0; jk < 2; ++jk) vt[jk] = *(const LAS bf16x8*)(B + RB_V + (16 * wave + fr) * 144 + (32 * jk + 8 * fq) * 2); \
        _Pragma("unroll") for (int tt = 0; tt < 4; ++tt) { \
            _Pragma("unroll") for (int cp = 0; cp < 4; ++cp) { const LAS unsigned char* qa = B + RB_Q + (16 * tt + fr) * 272 + (32 * cp + 4 * fq) * 2; qf[tt][cp][0] = *(const LAS u32x2*)qa; qf[tt][cp][1] = *(const LAS u32x2*)(qa + 32); } \
            _Pragma("unroll") for (int jk = 0; jk < 2; ++jk) af[tt][jk] = *(const LAS bf16x8*)(B + RB_A + (16 * tt + fr) * 144 + (32 * jk + 8 * fq) * 2); } \
        bf16x8 sop[4]; \
        _Pragma("unroll") for (int cp = 0; cp < 4; ++cp) { u32x4 w; w.x = cvt_pk_bf16(S[2 * cp][0], S[2 * cp][1]); w.y = cvt_pk_bf16(S[2 * cp][2], S[2 * cp][3]); w.z = cvt_pk_bf16(S[2 * cp + 1][0], S[2 * cp + 1][1]); w.w = cvt_pk_bf16(S[2 * cp + 1][2], S[2 * cp + 1][3]); \
            sop[cp] = __builtin_bit_cast(bf16x8, w); } \
        f32x4 o[4]; \
        _Pragma("unroll") for (int tt = 0; tt < 4; ++tt) o[tt] = (f32x4){0.f, 0.f, 0.f, 0.f}; \
        _Pragma("unroll") for (int cp = 0; cp < 4; ++cp) \
            _Pragma("unroll") for (int tt = 0; tt < 4; ++tt) { const u32x4 qw = (u32x4){qf[tt][cp][0].x, qf[tt][cp][0].y, qf[tt][cp][1].x, qf[tt][cp][1].y}; \
                o[tt] = __builtin_amdgcn_mfma_f32_16x16x32_bf16(sop[cp], __builtin_bit_cast(bf16x8, qw), o[tt], 0, 0, 0); } \
        _Pragma("unroll") for (int jk = 0; jk < 2; ++jk) \
            _Pragma("unroll") for (int tt = 0; tt < 4; ++tt) o[tt] = __builtin_amdgcn_mfma_f32_16x16x32_bf16(vt[jk], af[tt][jk], o[tt], 0, 0, 0); \
        __builtin_amdgcn_sched_barrier(0); \
        _Pragma("unroll") for (int tt = 0; tt < 4; ++tt) { const int row = r0 + 16 * tt + fr; \
            *(u32x2*)(zA + (size_t)row * ZLD + h * 256 + quarter * 64 + wave * 16 + 4 * fq) = pack4(o[tt]); \
            float sq = (o[tt][0] * o[tt][0] + o[tt][1] * o[tt][1]) + (o[tt][2] * o[tt][2] + o[tt][3] * o[tt][3]); sq += __shfl_xor(sq, 16); sq += __shfl_xor(sq, 32); \
            if (fq == 0) oss[(size_t)row * 64 + h * 16 + quarter * 4 + wave] = sq; } \
        _Pragma("unroll") for (int hf = 0; hf < 2; ++hf) { bf16x8 kf[4][2]; f32x4 dv[4]; \
            _Pragma("unroll") for (int c4 = 0; c4 < 4; ++c4) { const int ct = hf * 4 + c4; dv[c4] = *(const LAS f32x4*)(B + RB_D + (16 * ct + 4 * fq) * 4); \
                _Pragma("unroll") for (int jk = 0; jk < 2; ++jk) kf[c4][jk] = *(const LAS bf16x8*)(B + RB_K + (16 * ct + fr) * 144 + (32 * jk + 8 * fq) * 2); } \
            _Pragma("unroll") for (int c4 = 0; c4 < 4; ++c4) S[hf * 4 + c4] = S[hf * 4 + c4] * dv[c4]; \
            _Pragma("unroll") for (int jk = 0; jk < 2; ++jk) \
                _Pragma("unroll") for (int c4 = 0; c4 < 4; ++c4) S[hf * 4 + c4] = __builtin_amdgcn_mfma_f32_16x16x32_bf16(kf[c4][jk], vt[jk], S[hf * 4 + c4], 0, 0, 0); \
            __builtin_amdgcn_sched_barrier(0); } \
        } while (0)
    REC_LOAD(A, 0); REC_STORE(A, 0); REC_LOAD(B, 1);
    __syncthreads();
#pragma unroll 1
    for (int n = 0; n < 32; n += 2) {
        if (n + 2 < 32) REC_LOAD(A, n + 2);
        if (wave < 4) REC_STEP(n);
        REC_STORE(B, 1);
        __syncthreads();
        if (n + 3 < 32) REC_LOAD(B, n + 3);
        if (wave < 4) REC_STEP(n + 1);
        if (n + 2 < 32) REC_STORE(A, 0);
        __syncthreads();
    }
#undef REC_LOAD
#undef REC_STORE
#undef REC_STEP
    if (wave >= 4) return;
    float* so = p.out + OUT_NGP + (size_t)(b * 4 + h) * 128 * 256 + quarter * 64 + wave * 16 + fr;
#pragma unroll
    for (int ct = 0; ct < 8; ++ct)
#pragma unroll
        for (int r = 0; r < 4; ++r) so[(size_t)(16 * ct + 4 * fq + r) * 256] = S[ct][r];
}
__device__ __forceinline__ void gla_sample_item(const Params& p, LAS unsigned char* lds, int item) {
    unsigned char* ws = p.ws; bf16_t* zA = (bf16_t*)(ws + OFF_BIG); const float* gklr = (const float*)(ws + OFF_GKLR); float* oss = (float*)(ws + OFF_OSS);
    const int b = item >> 2, h = item & 3, r0 = MP + b * 4; const int tid = threadIdx.x, lane = tid & 63, wave = tid >> 6;
    LAS float* qe = (LAS float*)lds;
    LAS float* ke = qe + 512;
    LAS float* dl = ke + 512;
    LAS float* Ap = dl + 128;
    LAS float* vl = Ap + 32;
    LAS float* op = vl + 1024;
    for (int i = tid; i < 1024; i += 512) vl[i] = bf1(zA[(size_t)(r0 + (i >> 8)) * ZLD + 2048 + h * 256 + (i & 255)]);
    LAS float* gkl = op;
    if (tid >= 448) gkl[tid - 448] = gklr[(size_t)r0 * 16 + (tid - 448)];
    __syncthreads();
    if (tid < 128) { const int c = tid; float bl[4], qv[4], kv[4]; float run = 0.f; const float bg = p.in[13][h * 128 + c];
        float wup[16];
#pragma unroll
        for (int r = 0; r < 16; ++r) wup[r] = p.in[12][r * 512 + h * 128 + c];
#pragma unroll
        for (int t = 0; t < 4; ++t) { float x = bg;
#pragma unroll
            for (int r = 0; r < 16; ++r) x += gkl[t * 16 + r] * wup[r];
            run += logsig16(x); bl[t] = run; qv[t] = bf1(zA[(size_t)(r0 + t) * ZLD + 1024 + h * 128 + c]); kv[t] = bf1(zA[(size_t)(r0 + t) * ZLD + 1536 + h * 128 + c]); }
#pragma unroll
        for (int t = 0; t < 4; ++t) { qe[t * 128 + c] = qv[t] * __expf(bl[t]); ke[t * 128 + c] = kv[t] * __expf(bl[3] - bl[t]); }
        dl[c] = __expf(bl[3]);
#pragma unroll
        for (int i = 0; i < 4; ++i)
#pragma unroll
            for (int j = 0; j < 4; ++j) { float v = (j <= i) ? qv[i] * kv[j] * __expf(bl[i] - bl[j]) : 0.f; v = wave_sum(v); if (lane == 0) Ap[wave * 16 + i * 4 + j] = v; }
    }
    __syncthreads();
    const int vq = tid & 63, cp = tid >> 6;
    const float* S0 = p.in[5] + (size_t)item * 128 * 256; float* Sn = p.out + OUT_NGS + (size_t)item * 128 * 256;
    f32x4 vv[4];
#pragma unroll
    for (int j = 0; j < 4; ++j) vv[j] = *(const LAS f32x4*)(vl + j * 256 + vq * 4);
    f32x4 oa[4];
#pragma unroll
    for (int i = 0; i < 4; ++i) oa[i] = (f32x4){0.f, 0.f, 0.f, 0.f};
#pragma unroll 1
    for (int c8 = 0; c8 < 2; ++c8) {
    f32x4 s0r[8];
#pragma unroll
    for (int cc = 0; cc < 8; ++cc) s0r[cc] = __builtin_nontemporal_load((const f32x4*)(S0 + (size_t)(cp * 16 + c8 * 8 + cc) * 256 + vq * 4));
#pragma unroll
    for (int cc = 0; cc < 8; ++cc) { const int c = cp * 16 + c8 * 8 + cc; const f32x4 s = s0r[cc];
        f32x4 sn = s * dl[c];
#pragma unroll
        for (int j = 0; j < 4; ++j) sn += vv[j] * ke[j * 128 + c];
        *(f32x4*)(Sn + (size_t)c * 256 + vq * 4) = sn;
#pragma unroll
        for (int i = 0; i < 4; ++i) oa[i] += s * qe[i * 128 + c]; }
    }
#pragma unroll
    for (int i = 0; i < 4; ++i) *(LAS f32x4*)(op + (cp * 4 + i) * 256 + vq * 4) = oa[i];
    __syncthreads();
    if (tid < 256) { const int i = tid >> 6; f32x4 o = (f32x4){0.f, 0.f, 0.f, 0.f};
#pragma unroll
        for (int q = 0; q < 8; ++q) o += *(const LAS f32x4*)(op + (q * 4 + i) * 256 + vq * 4);
#pragma unroll
        for (int j = 0; j < 4; ++j) if (j <= i) o += vv[j] * (Ap[i * 4 + j] + Ap[16 + i * 4 + j]);
        *(u32x2*)(zA + (size_t)(r0 + i) * ZLD + h * 256 + vq * 4) = pack4(o);
        float sq = (o[0] * o[0] + o[1] * o[1]) + (o[2] * o[2] + o[3] * o[3]); sq = wave_sum(sq);
        if (lane < 16) oss[(size_t)(r0 + i) * 64 + h * 16 + lane] = (lane == 0) ? sq : 0.f; }
    __syncthreads();
}

__device__ __forceinline__ void conv_ffn2_idle(const Params& p, LAS unsigned char* lds, int G, int bid, int part, int nbusy) {
    if (bid < nbusy) return;
    const int tid = threadIdx.x; conv_ffn(p, 18, (bf16_t*)((unsigned char*)p.out + Y_FFN2_OFF), (LAS float*)(lds + (tid >> 6) * 16384), (bid - nbusy) * 8 + (tid >> 6), (G - nbusy) * 8, tid & 63, part);
}


template <class SE>
__device__ __forceinline__ void sample_gemm(const bf16_t* A, int lda, int a_pn_off, const bf16_t* Bt, int ldb, int K, int piece, const SE& E, LAS unsigned char* lds) {
    const int tid = threadIdx.x, lane = tid & 63, w8 = tid >> 6, w = w8 & 3, kh = w8 >> 2, mi = w >> 1, gi = w & 1, fr = lane & 15, fq = lane >> 4;
    const int mt2 = piece >> 4, cch = piece & 15, pn = cch >> 2, grp = 2 * (cch & 3) + gi;
    const int row = MP + 32 * mt2 + 16 * mi + fr, Kh = K >> 1;
    const bf16_t* ap = A + (size_t)row * lda + pn * a_pn_off + kh * Kh + 8 * fq;
    const bf16_t* bp0 = Bt + (size_t)(256 * pn + 32 * grp + fr) * ldb + kh * Kh + 8 * fq; const bf16_t* bp1 = bp0 + (size_t)16 * ldb;
    f32x4 acc0 = (f32x4){0.f, 0.f, 0.f, 0.f}, acc1 = (f32x4){0.f, 0.f, 0.f, 0.f};
    bf16x8 aA[4], b0A[4], b1A[4], aB[4], b0B[4], b1B[4];
#define SG_LD(T, kk) do { _Pragma("unroll") for (int j = 0; j < 4; ++j) { a##T[j] = *(const bf16x8*)(ap + (kk) + 32 * j); b0##T[j] = *(const bf16x8*)(bp0 + (kk) + 32 * j); b1##T[j] = *(const bf16x8*)(bp1 + (kk) + 32 * j); } } while (0)
#define SG_MM(T) do { _Pragma("unroll") for (int j = 0; j < 4; ++j) { acc0 = __builtin_amdgcn_mfma_f32_16x16x32_bf16(b0##T[j], a##T[j], acc0, 0, 0, 0); acc1 = __builtin_amdgcn_mfma_f32_16x16x32_bf16(b1##T[j], a##T[j], acc1, 0, 0, 0); } } while (0)
    SG_LD(A, 0);
#pragma unroll 1
    for (int k = 0; k < Kh; k += 256) {
        if (k + 128 < Kh) SG_LD(B, k + 128);
        SG_MM(A);
        if (k + 256 < Kh) SG_LD(A, k + 256);
        if (k + 128 < Kh) SG_MM(B);
    }
#undef SG_LD
#undef SG_MM
    LAS f32x4* xch = (LAS f32x4*)(lds + 4096);
    __syncthreads();
    if (kh == 1) { xch[(w * 64 + lane) * 2] = acc0; xch[(w * 64 + lane) * 2 + 1] = acc1; }
    __syncthreads();
    if (kh == 0) { acc0 += xch[(w * 64 + lane) * 2]; acc1 += xch[(w * 64 + lane) * 2 + 1]; }
    E(kh == 0, row, 256 * pn + 32 * grp + 8 * fq, pn, cch & 3, w, fr, fq, acc0, acc1, lds);
}
__device__ __forceinline__ void sample_ss(bool act, float sq, int row, int pn, int slot, int w, int fr, int fq, float* ssw, LAS unsigned char* lds) {
    LAS float* t = (LAS float*)lds; sq += __shfl_xor(sq, 16); sq += __shfl_xor(sq, 32);
    __syncthreads();
    if (act && fq == 0) t[w * 16 + fr] = sq;
    __syncthreads();
    if (act && fq == 0 && (w & 1) == 0) ssw[(size_t)row * 16 + pn * 4 + slot] = t[w * 16 + fr] + t[(w + 1) * 16 + fr];
}
struct SEpiResid { bf16_t* hb; float* ssw; float scale;
    __device__ __forceinline__ void operator()(bool act, int row, int c0, int pn, int slot, int w, int fr, int fq, f32x4 a0, f32x4 a1, LAS unsigned char* lds) const {
        bf16_t* hp = hb + (size_t)row * 1024 + c0; f32x4 v0 = (f32x4){0.f, 0.f, 0.f, 0.f}, v1 = v0;
        if (act) { const u32x4 r = *(const u32x4*)hp; v0 = unpack_lo(r) + a0 * scale; v1 = unpack_hi(r) + a1 * scale; *(u32x4*)hp = pack8(v0, v1); }
        sample_ss(act, ((v0[0] * v0[0] + v0[1] * v0[1]) + (v0[2] * v0[2] + v0[3] * v0[3])) + ((v1[0] * v1[0] + v1[1] * v1[1]) + (v1[2] * v1[2] + v1[3] * v1[3])), row, pn, slot, w, fr, fq, ssw, lds);
    } };
struct SEpiMix { bf16_t* sga; const bf16_t* P; const bf16_t* o; const float* oss;
    __device__ __forceinline__ void operator()(bool act, int row, int c0, int pn, int slot, int w, int fr, int fq, f32x4 a0, f32x4 a1, LAS unsigned char* lds) const {
        if (!act) return;
        const float rso = 1.0f / sqrtf(sum16(oss + (size_t)row * 64 + pn * 16) * (1.0f / 256.0f) + EPS);
        bf16_t* sp = sga + (size_t)row * 1024 + c0; const u32x4 sg = *(const u32x4*)sp, pv = *(const u32x4*)(P + (size_t)row * 1024 + c0), ov = *(const u32x4*)(o + (size_t)row * ZLD + c0);
        *(u32x4*)sp = pack8(unpack_lo(sg) * a0 + unpack_lo(pv) * (unpack_lo(ov) * rso), unpack_hi(sg) * a1 + unpack_hi(pv) * (unpack_hi(ov) * rso));
    } };
struct SEpiBf16 { bf16_t* out;
    __device__ __forceinline__ void operator()(bool act, int row, int c0, int pn, int slot, int w, int fr, int fq, f32x4 a0, f32x4 a1, LAS unsigned char* lds) const { if (act) *(u32x4*)(out + (size_t)row * 1024 + c0) = pack8(a0, a1); } };
struct SEpiPle { float* h; const bf16_t* hb; const bf16_t* pp; const float* ss; float* ssw;
    __device__ __forceinline__ void operator()(bool act, int row, int c0, int pn, int slot, int w, int fr, int fq, f32x4 a0, f32x4 a1, LAS unsigned char* lds) const {
        f32x4 v0 = (f32x4){0.f, 0.f, 0.f, 0.f}, v1 = v0;
        if (act) { const float rs = rowscale(ss, row, 1.0f / 1024.0f); const u32x4 hv = *(const u32x4*)(hb + (size_t)row * 1024 + c0), pv = *(const u32x4*)(pp + (size_t)row * 1024 + c0);
            v0 = unpack_lo(hv) + sigmoid4(a0 * rs) * unpack_lo(pv); v1 = unpack_hi(hv) + sigmoid4(a1 * rs) * unpack_hi(pv);
            *(f32x4*)(h + (size_t)row * 1024 + c0) = v0; *(f32x4*)(h + (size_t)row * 1024 + c0 + 4) = v1; }
        sample_ss(act, ((v0[0] * v0[0] + v0[1] * v0[1]) + (v0[2] * v0[2] + v0[3] * v0[3])) + ((v1[0] * v1[0] + v1[1] * v1[1]) + (v1[2] * v1[2] + v1[3] * v1[3])), row, pn, slot, w, fr, fq, ssw, lds);
    } };

#define XB_TMO      128
#define XB_XCNT(j)  (256  + 64 * (j))
#define XB_XSUB(j)  (1280 + 64 * (j))
#define XB_XGEN(j)  (2304 + 64 * (j))
#define XB_TOP      3328
#define XB_TOPGEN   3392
#define XCD_BAR_WORDS 3456
#define XB_SPIN_CAP (1u << 18)
__device__ __forceinline__ unsigned xb_ld(unsigned* p)              { return __hip_atomic_load(p, __ATOMIC_RELAXED, __HIP_MEMORY_SCOPE_AGENT); }
__device__ __forceinline__ unsigned xb_add(unsigned* p, unsigned v) { return __hip_atomic_fetch_add(p, v, __ATOMIC_RELAXED, __HIP_MEMORY_SCOPE_AGENT); }
__device__ __forceinline__ unsigned xb_xcc_id() { return (unsigned)__builtin_amdgcn_s_getreg((3 << 11) | 20) & 0xFu; }
#define XB_SPIN(cond, bar) do { unsigned _sp = 0; while (cond) { __builtin_amdgcn_s_sleep(1); \
    if ((++_sp & 255u) == 0u) { if (xb_ld(&(bar)[XB_TMO])) break; if (_sp > XB_SPIN_CAP) { atomicAdd(&(bar)[XB_TMO], 1u); break; } } } } while (0)
struct XcdBarrier { unsigned* bar; unsigned x; volatile LAS unsigned* st; };
__device__ __forceinline__ XcdBarrier xcd_barrier_post(unsigned* bar, volatile LAS unsigned* st) {
    XcdBarrier b; b.bar = bar; b.x = xb_xcc_id(); b.st = st;
    if (threadIdx.x == 0) (void)xb_add(&bar[XB_XCNT(b.x)], 1u);
    return b;
}
__device__ __forceinline__ void xcd_barrier_complete(unsigned* bar, unsigned x, unsigned& nloc, unsigned& nx) {
    const unsigned G = gridDim.x * gridDim.y * gridDim.z;
    unsigned sum, cnt, mine, sp = 0u;
    for (;;) {
        sum = 0u; cnt = 0u; mine = 0u;
#pragma unroll
        for (unsigned j = 0; j < 16; ++j) { const unsigned c = xb_ld(&bar[XB_XCNT(j)]); sum += c; cnt += (c > 0u) ? 1u : 0u; mine = (j == x) ? c : mine; }
        if (sum == G) break;
        __builtin_amdgcn_s_sleep(1);
        if ((++sp & 255u) == 0u) { if (xb_ld(&bar[XB_TMO])) break; if (sp > XB_SPIN_CAP) { atomicAdd(&bar[XB_TMO], 1u); break; } }
    }
    nloc = mine > 0u ? mine : 1u; nx = cnt > 0u ? cnt : 1u;
}
__device__ __forceinline__ void xcd_barrier(const XcdBarrier& b) {
    asm volatile("s_waitcnt vmcnt(0)" ::: "memory");
    __syncthreads();
    if (threadIdx.x == 0) {
        unsigned* bar = b.bar;
        __builtin_amdgcn_s_waitcnt(0);
        unsigned nloc = b.st[0], nx = b.st[1];
        if (nloc == 0u) { xcd_barrier_complete(bar, b.x, nloc, nx); b.st[0] = nloc; b.st[1] = nx; }
        const unsigned old = xb_add(&bar[XB_XSUB(b.x)], 1u);
        const unsigned gen = old / nloc;
        if (old + 1u == (gen + 1u) * nloc) {
            __builtin_amdgcn_fence(__ATOMIC_RELEASE, "agent");
            asm volatile("s_waitcnt vmcnt(0)" ::: "memory");
            const unsigned og = xb_add(&bar[XB_TOP], 1u);
            const unsigned tg = og / nx;
            if (og + 1u == (tg + 1u) * nx) xb_add(&bar[XB_TOPGEN], 1u);
            else XB_SPIN(xb_ld(&bar[XB_TOPGEN]) == tg, bar);
            __builtin_amdgcn_fence(__ATOMIC_ACQUIRE, "agent");
            xb_add(&bar[XB_XGEN(b.x)], 1u);
            asm volatile("s_waitcnt vmcnt(0)" ::: "memory");
        } else {
            XB_SPIN(xb_ld(&bar[XB_XGEN(b.x)]) == gen, bar);
            __builtin_amdgcn_fence(__ATOMIC_ACQUIRE, "agent");
            asm volatile("s_waitcnt vmcnt(0)" ::: "memory");
        }
    }
    __syncthreads();
}
__global__ void __launch_bounds__(512, 2) fwd_megakernel(Params p) {
    extern __shared__ __attribute__((aligned(16))) unsigned char lds_raw[];
    LAS unsigned char* lds = (LAS unsigned char*)lds_raw;
    cg::grid_group grid = cg::this_grid();
    unsigned char* ws = p.ws; const int G = gridDim.x, bid = blockIdx.x;
    bf16_t* hb = (bf16_t*)(ws + OFF_HB); bf16_t* big = (bf16_t*)(ws + OFF_BIG); bf16_t* sga = (bf16_t*)(ws + OFF_SGA); bf16_t* Pb = (bf16_t*)(ws + OFF_P);
    float* ssa = (float*)(ws + OFF_SSA); float* ssb = (float*)(ws + OFF_SSB); float* hres = p.out;
    const bf16_t* w1t = (const bf16_t*)(ws + OFF_WFFN); const bf16_t* w2t = (const bf16_t*)(ws + OFF_WFFN + SZ_W1T);
    const int lo = p.ph_lo, hi = p.ph_hi;
#ifndef PHMASK
#define PHMASK 0xFFF
#endif
#define IN(k) (((PHMASK >> (k)) & 1) && lo <= (k) && (k) < hi)
#define SEAM0() do { if (IN(0) && IN(1)) { asm volatile("s_waitcnt vmcnt(0) lgkmcnt(0)" ::: "memory"); grid.sync(); if (threadIdx.x < 64) { __builtin_amdgcn_fence(__ATOMIC_ACQUIRE, "agent"); asm volatile("s_waitcnt vmcnt(0)" ::: "memory"); } __syncthreads(); } } while (0)
#define SEAM(k) do { if (IN(k) && IN((k) + 1)) xcd_barrier(xbar); } while (0)
    unsigned* barw = (unsigned*)ws + 1024; volatile LAS unsigned* bst = (volatile LAS unsigned*)(lds + RS_OFF + 15360);
    if (threadIdx.x < 2) bst[threadIdx.x] = 0u;
    XcdBarrier xbar; xbar.bar = barw; xbar.x = 0; xbar.st = bst;
    if (lo == 0 && hi == NPH) xbar = xcd_barrier_post(barw, bst);
    if (lo < 0) grid.sync();
    if (IN(0)) phase_prep(p, lds);
    SEAM(0);
    if (IN(1)) { pg8::Gemm g{hb, w1t, 1024, 1024, 1024, 0}; pg8::StaticOrder S; S.init(M, 5632, G, bid); fill_rs(lds, S, ssa); EpiSwiglu E{big, (const LAS float*)(lds + RS_OFF)}; pg8::gemm_phase(lds, g, S, E);
        const int nb = (66 * 22) % G; if (bid >= nb) conv_rest(p, lds, (bid - nb) * 8 + (threadIdx.x >> 6), (G - nb) * 8); }
    SEAM(1);
    if (IN(2)) { pg8::Gemm g{big, w2t, FF, FF, FF, 0}; pg8::StaticOrder S; S.init(MP, 1024, G, bid); EpiResid E{hb, ssb, 0.5f}; pg8::gemm_phase(lds, g, S, E);
        for (int pc = bid; pc < 256; pc += G) { SEpiResid SE{hb, ssb, 0.5f}; sample_gemm(big, FF, 0, w2t, FF, FF, pc, SE, lds); }
    }
    SEAM(2);
    if (IN(3)) { pg8::Gemm g{hb, (const bf16_t*)(ws + OFF_WIN), 1024, 1024, 1024, 0}; pg8::StaticOrder S; S.init(M, NIN, G, bid);
        fill_rs(lds, S, ssb); EpiZ E{big, sga, Pb, (float*)(ws + OFF_GKLR), (const LAS float*)(lds + RS_OFF), p.in[14]}; pg8::gemm_phase(lds, g, S, E);
        conv_ffn2_idle(p, lds, G, bid, 0, (66 * 25) % G); }
    SEAM(3);
    if (IN(4)) {
        { PrepPf pf; if (bid < 1024) prep_prefetch(p, bid, pf);
          for (int it = bid; it < 1024; it += G) gla_prep_item(p, lds, it, pf, (it + G < 1024) ? it + G : -1); }
        int it0 = bid; while (it0 < 1024) it0 += G;
        for (int it = it0; it < 1024 + 256 + 128; it += G) {
            if (it < 1280) pool_prompt_item(p, it - 1024);
            else pool_sample_item(p, it - 1280);
        }
    }
    SEAM(4);
    if (IN(5)) {
        if (G >= 192) { if (bid < 128) gla_rec_item(p, lds, bid); else for (int it = bid - 128; it < 512; it += G - 128) gla_sample_item(p, lds, it); }
        else for (int it = bid; it < 640; it += G) { if (it < 128) gla_rec_item(p, lds, it); else gla_sample_item(p, lds, it - 128); }
    }
    SEAM(5);
    if (IN(6)) { pg8::Gemm g{(const bf16_t*)p.out, (const bf16_t*)(ws + OFF_WPT), 256, 1024, 256, 512}; pg8::StaticOrder S; S.init(MP, 1024, G, bid);
        fill_rso(lds, S, (const float*)(ws + OFF_OSS)); EpiMix E{sga, Pb, big, (const LAS float*)(lds + RS_OFF)}; pg8::gemm_phase(lds, g, S, E);
        for (int pc = bid; pc < 256; pc += G) { SEpiMix SE{sga, Pb, big, (const float*)(ws + OFF_OSS)}; sample_gemm((const bf16_t*)p.out, 1024, 256, (const bf16_t*)(ws + OFF_WPT), 256, 256, pc, SE, lds); }
    }
    SEAM(6);
    if (IN(7)) {
        pg8::Gemm g{sga, (const bf16_t*)(ws + OFF_WOUT), 1024, 1024, 1024, 0}; pg8::StaticOrder S; S.init(MP, 1024, G, bid);
        EpiResid E{hb, ssa, 1.0f}; pg8::gemm_phase(lds, g, S, E);
        for (int pc = bid; pc < 256; pc += G) { SEpiResid SE{hb, ssa, 1.0f}; sample_gemm(sga, 1024, 0, (const bf16_t*)(ws + OFF_WOUT), 1024, 1024, pc, SE, lds); }
    }
    SEAM(7);
    const bf16_t* w1t2 = (const bf16_t*)((const unsigned char*)p.out + Y_FFN2_OFF); const bf16_t* w2t2 = w1t2 + SZ_W1T / 2;
    if (IN(8)) { pg8::Gemm g{hb, w1t2, 1024, 1024, 1024, 0}; pg8::StaticOrder S; S.init(M, 5632, G, bid); fill_rs(lds, S, ssa); EpiSwiglu E{big, (const LAS float*)(lds + RS_OFF)}; pg8::gemm_phase(lds, g, S, E); }
    SEAM(8);
    if (IN(9)) {
        { pg8::Gemm g{big, w2t2, FF, FF, FF, 0}; pg8::StaticOrder S; S.init(MP, 1024, G, bid); EpiResid E{hb, ssb, 0.5f}; pg8::gemm_phase(lds, g, S, E); }
        { pg8::Gemm g{(const bf16_t*)(ws + OFF_PB), (const bf16_t*)(ws + OFF_WPP), 256, 256, 256, 0}; pg8::StaticOrder S; S.init(MP, 1024, G, bid); EpiBf16 E{Pb}; pg8::gemm_phase(lds, g, S, E); }
        for (int pc = bid; pc < 256; pc += G) { SEpiResid SE{hb, ssb, 0.5f}; sample_gemm(big, FF, 0, w2t2, FF, FF, pc, SE, lds); }
        for (int pc = G - 1 - bid; pc < 256; pc += G) { SEpiBf16 SE{Pb}; sample_gemm((const bf16_t*)(ws + OFF_PB), 256, 0, (const bf16_t*)(ws + OFF_WPP), 256, 256, pc, SE, lds); }
    }
    SEAM(9);
    if (IN(10)) { pg8::Gemm g{hb, (const bf16_t*)(ws + OFF_WPG), 1024, 1024, 1024, 0}; pg8::StaticOrder S; S.init(MP, 1024, G, bid); fill_rs(lds, S, ssb); EpiPle E{hres, hb, Pb, (const LAS float*)(lds + RS_OFF), ssa}; pg8::gemm_phase(lds, g, S, E);
        for (int pc = bid; pc < 256; pc += G) { SEpiPle SE{hres, hb, Pb, ssb, ssa}; sample_gemm(hb, 1024, 0, (const bf16_t*)(ws + OFF_WPG), 1024, 1024, pc, SE, lds); } }
    SEAM(10);
    if (IN(11)) {
        const int tid = threadIdx.x, lane = tid & 63, gw = bid * 8 + (tid >> 6), NGW = G * 8;
        for (int row = gw; row < M; row += NGW) { const float rs = rowscale(ssa, row, 1.0f / 1024.0f); float* hr = hres + (size_t)row * 1024;
#pragma unroll
            for (int j = 0; j < 4; ++j) { const f32x4 v = __builtin_nontemporal_load((const f32x4*)(hr + j * 256 + lane * 4)); const f32x4 fn = *(const f32x4*)(p.in[25] + j * 256 + lane * 4); __builtin_nontemporal_store(v * rs * fn, (f32x4*)(hr + j * 256 + lane * 4)); } }
    }

#ifdef DUMP
    { asm volatile("s_waitcnt vmcnt(0) lgkmcnt(0)" ::: "memory"); grid.sync(); __builtin_amdgcn_fence(__ATOMIC_ACQUIRE, "agent"); asm volatile("s_waitcnt vmcnt(0)" ::: "memory");
      const size_t n = (size_t)M * 1024;
      for (size_t i = (size_t)bid * 512 + threadIdx.x; i < n; i += (size_t)G * 512) { const size_t row = i >> 10, col = i & 1023;
#if DUMP == 1
        hres[i] = bf1(sga[i]);
#elif DUMP == 2
        hres[i] = bf1(hb[i]); (void)row; (void)col;
#elif DUMP == 3
        hres[i] = bf1(Pb[i]); if (row < MP) p.out[OUT_NGS + i] = ((const float*)(ws + OFF_OSS))[row * 64 + (col & 63)];
#endif
      } }
#endif
#undef IN
#undef SEAM
}


#ifndef MK_SPLIT
#define MK_SPLIT 0
#endif
extern "C" void kernel_launch(void* const* d_in, const int* in_sizes, int n_in, void* d_out, int out_size, void* d_ws, size_t ws_size, hipStream_t stream) {
    static int grid_blocks = 0;
    if (!grid_blocks) {
        int dev = 0, cus = 0, per_cu = 0;
        hipGetDevice(&dev); hipDeviceGetAttribute(&cus, hipDeviceAttributeMultiprocessorCount, dev);
        hipFuncSetAttribute((const void*)fwd_megakernel, hipFuncAttributeMaxDynamicSharedMemorySize, LDS_BYTES);
        hipOccupancyMaxActiveBlocksPerMultiprocessor(&per_cu, (const void*)fwd_megakernel, 512, LDS_BYTES);
        if (per_cu < 1) { fprintf(stderr, "kernel_launch: occupancy query says %d blocks per CU\n", per_cu); per_cu = 1; }
        if (per_cu > 1) per_cu = 1;
        grid_blocks = cus * per_cu;
        if (ws_size < WS_END) fprintf(stderr, "kernel_launch: workspace too small (%zu < %zu)\n", ws_size, (size_t)WS_END);
    }
#ifdef DIAG_MEMSET
    hipMemsetAsync(d_ws, 0xAA, WS_END, stream);
#endif
    (void)hipMemsetAsync((unsigned char*)d_ws + 4096, 0, XCD_BAR_WORDS * 4, stream);
    Params p{};
    for (int i = 0; i < 26; ++i) p.in[i] = (const float*)d_in[i];
    p.out = (float*)d_out; p.ws = (unsigned char*)d_ws;
#if MK_SPLIT
    for (int ph = 0; ph < NPH; ++ph) { p.ph_lo = ph; p.ph_hi = ph + 1; void* args[] = {&p};
        hipError_t e = hipLaunchCooperativeKernel((const void*)fwd_megakernel, dim3(grid_blocks), dim3(512), args, LDS_BYTES, stream);
        if (e != hipSuccess) fprintf(stderr, "launch %d failed: %s\n", ph, hipGetErrorString(e)); }
#else
    p.ph_lo = 0; p.ph_hi = NPH; void* args[] = {&p};
    hipError_t e = hipLaunchCooperativeKernel((const void*)fwd_megakernel, dim3(grid_blocks), dim3(512), args, LDS_BYTES, stream);
    if (e != hipSuccess) fprintf(stderr, "cooperative launch failed: %s (grid %d)\n", hipGetErrorString(e), grid_blocks);
#endif
}
```

```cpp
#include <hip/hip_runtime.h>
#include <hip/hip_cooperative_groups.h>
#include <cstdio>
namespace cg = cooperative_groups;

#define LAS __attribute__((address_space(3)))
typedef unsigned short bf16_t;
typedef short bf16x8 __attribute__((ext_vector_type(8)));
typedef float f32x4 __attribute__((ext_vector_type(4)));
typedef float f32x2 __attribute__((ext_vector_type(2)));
typedef unsigned u32x4 __attribute__((ext_vector_type(4)));
typedef unsigned u32x2 __attribute__((ext_vector_type(2)));

constexpr int MP = 16384, MS = 512, M = MP + MS, D = 1024, FF = 2816, NIN = 6400, WIN_LD = 6160, ZLD = 3072;
constexpr float EPS = 1e-6f;
constexpr int NPH = 12;
constexpr size_t MiB = (size_t)1 << 20;
constexpr size_t OFF_WFFN = 1 * MiB;
constexpr size_t SZ_W1T = (size_t)5632 * 1024 * 2;
constexpr size_t OFF_AT = OFF_WFFN;
constexpr size_t OFF_DECL = OFF_AT + (size_t)1024 * 4096 * 2;
constexpr size_t OFF_GKLR = OFF_DECL + (size_t)1024 * 128 * 4;
constexpr size_t OFF_OSS = OFF_GKLR + (size_t)M * 16 * 4;
static_assert(OFF_OSS + (size_t)M * 64 * 4 <= OFF_WFFN + (size_t)3 * 1024 * 2816 * 2, "overlay fits");
constexpr size_t OFF_WIN = 18 * MiB;
constexpr size_t OFF_WPT = OFF_WIN + (size_t)NIN * 1024 * 2;
constexpr size_t OFF_WOUT = OFF_WPT + (size_t)1024 * 256 * 2;
constexpr size_t OFF_WPG = OFF_WOUT + (size_t)1024 * 1024 * 2;
constexpr size_t OFF_WPP = OFF_WPG + (size_t)1024 * 1024 * 2;
static_assert(OFF_WPP + (size_t)1024 * 256 * 2 <= 36 * MiB, "w rest");
constexpr size_t OFF_HB = 36 * MiB;
constexpr size_t OFF_BIG = 69 * MiB;
constexpr size_t OFF_SGA = 168 * MiB;
constexpr size_t OFF_P = 201 * MiB;
constexpr size_t OFF_PB = 234 * MiB;
constexpr size_t OFF_SSA = 243 * MiB;
constexpr size_t OFF_SSB = 245 * MiB;
constexpr size_t WS_END = 247 * MiB;
constexpr size_t OUT_NPP = (size_t)M * 1024;
constexpr size_t OUT_NGP = OUT_NPP + (size_t)8 * 15 * 1024;
constexpr size_t OUT_NPS = OUT_NGP + (size_t)8 * 4 * 128 * 256;
constexpr size_t OUT_NGS = OUT_NPS + (size_t)128 * 15 * 1024;
constexpr int LDS_BYTES = 147456;

typedef __bf16 bf16v2_t __attribute__((ext_vector_type(2)));
__device__ __forceinline__ unsigned cvt_pk_bf16(float lo, float hi) { bf16v2_t v; v[0] = (__bf16)lo; v[1] = (__bf16)hi; return __builtin_bit_cast(unsigned, v); }
__device__ __forceinline__ float bf_lo(unsigned w) { return __uint_as_float(w << 16); }
__device__ __forceinline__ float bf_hi(unsigned w) { return __uint_as_float(w & 0xffff0000u); }
__device__ __forceinline__ float bf1(bf16_t b) { return __uint_as_float(((unsigned)b) << 16); }
__device__ __forceinline__ bf16_t f2bf(float f) { return (bf16_t)(cvt_pk_bf16(f, 0.f) & 0xffffu); }
__device__ __forceinline__ u32x2 pack4(f32x4 v) { u32x2 w; w.x = cvt_pk_bf16(v[0], v[1]); w.y = cvt_pk_bf16(v[2], v[3]); return w; }
__device__ __forceinline__ u32x4 pack8(f32x4 a, f32x4 b) { u32x4 w; w.x = cvt_pk_bf16(a[0], a[1]); w.y = cvt_pk_bf16(a[2], a[3]); w.z = cvt_pk_bf16(b[0], b[1]); w.w = cvt_pk_bf16(b[2], b[3]); return w; }
__device__ __forceinline__ f32x4 unpack_lo(u32x4 w) { return (f32x4){bf_lo(w.x), bf_hi(w.x), bf_lo(w.y), bf_hi(w.y)}; }
__device__ __forceinline__ f32x4 unpack_hi(u32x4 w) { return (f32x4){bf_lo(w.z), bf_hi(w.z), bf_lo(w.w), bf_hi(w.w)}; }
__device__ __forceinline__ f32x4 unpack4(u32x2 w) { return (f32x4){bf_lo(w.x), bf_hi(w.x), bf_lo(w.y), bf_hi(w.y)}; }
__device__ __forceinline__ float sigmoidf_(float x) { return __builtin_amdgcn_rcpf(1.0f + __builtin_amdgcn_exp2f(-1.4426950409f * x)); }
__device__ __forceinline__ f32x4 sigmoid4(f32x4 x) { return (f32x4){sigmoidf_(x[0]), sigmoidf_(x[1]), sigmoidf_(x[2]), sigmoidf_(x[3])}; }
__device__ __forceinline__ float sum16(const float* p) { const f32x4* q = (const f32x4*)p; const f32x4 a = q[0], b = q[1], c = q[2], d = q[3];
    return ((a[0] + a[1]) + (a[2] + a[3])) + ((b[0] + b[1]) + (b[2] + b[3])) + ((c[0] + c[1]) + (c[2] + c[3])) + ((d[0] + d[1]) + (d[2] + d[3])); }
__device__ __forceinline__ float rowscale(const float* ss, int row, float invn) { return 1.0f / sqrtf(sum16(ss + (size_t)row * 16) * invn + EPS); }
__device__ __forceinline__ float wave_sum(float v) {
#pragma unroll
    for (int o = 1; o < 64; o <<= 1) v += __shfl_xor(v, o);
    return v; }

namespace pg8 {
constexpr int BM = 256, BK = 64, HALF = 128, HTB = HALF * BK * 2, NXCD = 8, WGM = 4;
__device__ __forceinline__ int lds_byte(int r, int c) { const int st = (r >> 4) * 2 + (c >> 5), rr = r & 15, cc = c & 31, ob = rr * 64 + cc * 2; return st * 1024 + (ob ^ (((ob >> 9) & 1) << 5)); }
__device__ __forceinline__ void stage_rc(int b, int& R, int& C) { const int st = b / 1024, sb = b % 1024, swz = sb ^ (((sb >> 9) & 1) << 5); R = (st >> 1) * 16 + swz / 64; C = (st & 1) * 32 + (swz % 64) / 2; }
struct Unit { int pm, pn; };
struct Gemm { const bf16_t* A; const bf16_t* Bt; int K, lda, ldb, a_pn_off; };
struct StaticOrder {
    int nM, nN, nwg, G, c;
    __device__ void init(int M_, int N_, int G_, int c_) { nM = M_ / BM; nN = N_ / BM; nwg = nM * nN; G = G_; c = c_; }
    __device__ bool next(int i, Unit& u) const {
        const long L = (long)i * G + c; if (L >= nwg) return false;
        int wgid = (int)L; { const int q = nwg / NXCD, r = nwg % NXCD, xcd = wgid % NXCD, off = wgid / NXCD; wgid = (xcd < r ? xcd * (q + 1) : r * (q + 1) + (xcd - r) * q) + off; }
        const int nig = WGM * nN, gid = wgid / nig, fm = gid * WGM, gsz = (nM - fm) < WGM ? (nM - fm) : WGM;
        u.pm = fm + ((wgid % nig) % gsz); u.pn = (wgid % nig) / gsz; return true;
    }
};
template <class Epi>
__device__ __forceinline__ void gemm_phase(LAS unsigned char* lds, const Gemm g, const StaticOrder& S, const Epi& E) {
    const int tid = threadIdx.x, wid = __builtin_amdgcn_readfirstlane(tid >> 6), lane = tid & 63, wr = wid >> 2, wc = wid & 3, fr = lane & 15, fq = lane >> 4;
    int K_ = g.K; asm volatile("" : "+s"(K_));
    const int K = K_, nt = K / BK;
    unsigned voffA[2], voffB[2];
#pragma unroll
    for (int i = 0; i < 2; ++i) { int R, C; stage_rc(tid * 16 + i * 8192, R, C); voffA[i] = (unsigned)(R * g.lda + C) * 2u; voffB[i] = (unsigned)(R * g.ldb + C) * 2u; }
    const size_t kstep = (size_t)(BK * 2);
    const size_t hsA = (size_t)HALF * g.lda * 2, hsB = (size_t)HALF * g.ldb * 2, tsA = 2 * hsA, tsB = 2 * hsB;
    const unsigned ldsw = (unsigned)wid * 1024u;
    const int aoff = lds_byte(wr * 64 + fr, fq * 8), boff = lds_byte(wc * 32 + fr, fq * 8);
#define PG8_SA(b, h) (((b) * 2 + (h)) * HTB)
#define PG8_SB(b, h) ((4 + (b) * 2 + (h)) * HTB)
#define PG8_STAGE(bufoff, gbase, voff) do { _Pragma("unroll") for (int _i = 0; _i < 2; ++_i) \
        __builtin_amdgcn_global_load_lds((const unsigned*)((const char*)(gbase) + (voff)[_i]), (LAS unsigned*)(lds + (bufoff) + ldsw + _i * 8192), 16, 0, 0); } while (0)
#define PG8_LDA(dst, b, h) do { _Pragma("unroll") for (int m = 0; m < 4; ++m) _Pragma("unroll") for (int k = 0; k < 2; ++k) dst[m][k] = *(const LAS bf16x8*)(lds + PG8_SA(b, h) + aoff + m * 2048 + k * 1024); } while (0)
#define PG8_LDB(dst, b, h) do { _Pragma("unroll") for (int n = 0; n < 2; ++n) _Pragma("unroll") for (int k = 0; k < 2; ++k) dst[n][k] = *(const LAS bf16x8*)(lds + PG8_SB(b, h) + boff + n * 2048 + k * 1024); } while (0)
#define PG8_MMA(ai, bj, At, Bt) do { __builtin_amdgcn_s_setprio(1); _Pragma("unroll") for (int m = 0; m < 4; ++m) _Pragma("unroll") for (int n = 0; n < 2; ++n) _Pragma("unroll") for (int k = 0; k < 2; ++k) \
        acc[ai][bj][m][n] = __builtin_amdgcn_mfma_f32_16x16x32_bf16(Bt[n][k], At[m][k], acc[ai][bj][m][n], 0, 0, 0); __builtin_amdgcn_s_setprio(0); } while (0)
#define PG8_WAIT_V(n) asm volatile("s_waitcnt vmcnt(" #n ")" ::: "memory")
#define PG8_WAIT_L(n) asm volatile("s_waitcnt lgkmcnt(" #n ")" ::: "memory")
#define PG8_BAR __builtin_amdgcn_s_barrier()
#define PG8_SCHED __builtin_amdgcn_sched_barrier(0)
    Unit cur, nxt; int ui = 0;
    if (!S.next(0, cur)) return;
    f32x4 acc[2][2][4][2];
#pragma unroll
    for (int a = 0; a < 2; ++a)
#pragma unroll
        for (int b = 0; b < 2; ++b)
#pragma unroll
            for (int m = 0; m < 4; ++m)
#pragma unroll
                for (int n = 0; n < 2; ++n) acc[a][b][m][n] = (f32x4){0.f, 0.f, 0.f, 0.f};
    bf16x8 At[4][2], B0[2][2], B1[2][2];
    const char* cA = (const char*)g.A + (size_t)cur.pm * tsA + (size_t)cur.pn * g.a_pn_off; const char* cB = (const char*)g.Bt + (size_t)cur.pn * tsB;
    PG8_STAGE(PG8_SB(0, 0), cB, voffB); PG8_STAGE(PG8_SA(0, 0), cA, voffA); PG8_STAGE(PG8_SB(0, 1), cB + hsB, voffB); PG8_STAGE(PG8_SA(0, 1), cA + hsA, voffA);
    if (wr == 1) PG8_BAR;
    PG8_WAIT_V(4); PG8_BAR;
    PG8_STAGE(PG8_SB(1, 0), cB + kstep, voffB); PG8_STAGE(PG8_SA(1, 0), cA + kstep, voffA); PG8_STAGE(PG8_SB(1, 1), cB + hsB + kstep, voffB);
    PG8_WAIT_V(6); PG8_BAR;
    for (;;) {
        const bool has_next = S.next(ui + 1, nxt);
        const char* nA = has_next ? (const char*)g.A + (size_t)nxt.pm * tsA + (size_t)nxt.pn * g.a_pn_off : cA; const char* nB = has_next ? (const char*)g.Bt + (size_t)nxt.pn * tsB : cB;
#pragma unroll 1
        for (int t = 0; t < nt; t += 2) {
            const bool last = (t == nt - 2);
            const char* a1 = cA + (size_t)(t + 1) * kstep;
            const char* a2 = last ? nA : cA + (size_t)(t + 2) * kstep; const char* b2 = last ? nB : cB + (size_t)(t + 2) * kstep;
            const char* a3 = a2 + kstep; const char* b3 = b2 + kstep;
            PG8_LDB(B0, 0, 0); PG8_SCHED; PG8_LDA(At, 0, 0); PG8_STAGE(PG8_SA(1, 1), a1 + hsA, voffA);
            PG8_WAIT_L(8); PG8_BAR; PG8_WAIT_L(0); PG8_MMA(0, 0, At, B0); PG8_BAR; PG8_SCHED;
            PG8_LDB(B1, 0, 1); PG8_STAGE(PG8_SB(0, 0), b2, voffB);
            PG8_BAR; PG8_WAIT_L(0); PG8_MMA(0, 1, At, B1); PG8_BAR;
            PG8_LDA(At, 0, 1); PG8_STAGE(PG8_SA(0, 0), a2, voffA);
            PG8_BAR; PG8_WAIT_L(0); PG8_MMA(1, 0, At, B0); PG8_BAR; PG8_SCHED;
            PG8_STAGE(PG8_SB(0, 1), b2 + hsB, voffB);
            PG8_WAIT_V(6); PG8_BAR; PG8_MMA(1, 1, At, B1); PG8_BAR;
            PG8_LDB(B0, 1, 0); PG8_SCHED; PG8_LDA(At, 1, 0); PG8_STAGE(PG8_SA(0, 1), a2 + hsA, voffA);
            PG8_WAIT_L(8); PG8_BAR; PG8_WAIT_L(0); PG8_MMA(0, 0, At, B0); PG8_BAR; PG8_SCHED;
            PG8_LDB(B1, 1, 1); PG8_STAGE(PG8_SB(1, 0), b3, voffB);
            PG8_BAR; PG8_WAIT_L(0); PG8_MMA(0, 1, At, B1); PG8_BAR;
            PG8_LDA(At, 1, 1); PG8_STAGE(PG8_SA(1, 0), a3, voffA);
            PG8_BAR; PG8_WAIT_L(0); PG8_MMA(1, 0, At, B0); PG8_BAR; PG8_SCHED;
            PG8_STAGE(PG8_SB(1, 1), b3 + hsB, voffB);
            PG8_WAIT_V(6); PG8_BAR; PG8_MMA(1, 1, At, B1); PG8_BAR;
        }
        E(acc, cur, ui, wr, wc, fr, fq);
        if (!has_next) break;
#pragma unroll
        for (int a = 0; a < 2; ++a)
#pragma unroll
            for (int b = 0; b < 2; ++b)
#pragma unroll
                for (int m = 0; m < 4; ++m)
#pragma unroll
                    for (int n = 0; n < 2; ++n) acc[a][b][m][n] = (f32x4){0.f, 0.f, 0.f, 0.f};
        cur = nxt; cA = nA; cB = nB; ++ui;
    }
    PG8_WAIT_V(0);
    if (wr == 0) PG8_BAR;
    PG8_BAR;
#undef PG8_SA
#undef PG8_SB
#undef PG8_STAGE
#undef PG8_LDA
#undef PG8_LDB
#undef PG8_MMA
#undef PG8_WAIT_V
#undef PG8_WAIT_L
#undef PG8_BAR
#undef PG8_SCHED
}
}
using pg8::Unit;
typedef const f32x4 (&AccRef)[2][2][4][2];
constexpr int RS_OFF = 131072;
__device__ __forceinline__ void fill_rs(LAS unsigned char* lds, const pg8::StaticOrder& S, const float* ss) {
    LAS float* tab = (LAS float*)(lds + RS_OFF); Unit u; const int wave = threadIdx.x >> 6, lane = threadIdx.x & 63;
    if (S.next(wave, u)) { float v[4];
#pragma unroll
        for (int k = 0; k < 4; ++k) v[k] = sum16(ss + (size_t)(u.pm * 256 + lane + 64 * k) * 16);
#pragma unroll
        for (int k = 0; k < 4; ++k) tab[wave * 256 + lane + 64 * k] = 1.0f / sqrtf(v[k] * (1.0f / 1024.0f) + EPS); }
    __syncthreads();
}
__device__ __forceinline__ void fill_rso(LAS unsigned char* lds, const pg8::StaticOrder& S, const float* oss) {
    LAS float* tab = (LAS float*)(lds + RS_OFF); Unit u; const int wave = threadIdx.x >> 6, lane = threadIdx.x & 63;
    if (S.next(wave, u)) { float v[4];
#pragma unroll
        for (int k = 0; k < 4; ++k) v[k] = sum16(oss + (size_t)(u.pm * 256 + lane + 64 * k) * 64 + u.pn * 16);
#pragma unroll
        for (int k = 0; k < 4; ++k) tab[wave * 256 + lane + 64 * k] = 1.0f / sqrtf(v[k] * (1.0f / 256.0f) + EPS); }
    __syncthreads();
}
struct EpiSwiglu { bf16_t* act; const LAS float* rs_tab;
    __device__ __forceinline__ void operator()(AccRef acc, const Unit& u, int ui, int wr, int wc, int fr, int fq) const {
        const int rl0 = wr * 64 + fr; const LAS float* tab = rs_tab + ui * 256 + rl0;
        bf16_t* base = act + (size_t)(u.pm * 256 + rl0) * FF + u.pn * 128 + wc * 32 + fq * 8;
#pragma unroll
        for (int ai = 0; ai < 2; ++ai)
#pragma unroll
            for (int m = 0; m < 4; ++m) { const int rl = ai * 128 + m * 16; const float rs = tab[rl]; f32x4 o[2];
#pragma unroll
                for (int bj = 0; bj < 2; ++bj) { const f32x4 gt = acc[ai][bj][m][0] * rs, up = acc[ai][bj][m][1] * rs; o[bj] = gt * sigmoid4(gt) * up; }
                *(u32x4*)(base + (size_t)rl * FF) = pack8(o[0], o[1]); }
    } };
struct EpiResid { bf16_t* hb; float* ssw; float scale;
    __device__ __forceinline__ void operator()(AccRef acc, const Unit& u, int ui, int wr, int wc, int fr, int fq) const {
        const int row0 = u.pm * 256 + wr * 64 + fr, col0 = u.pn * 256 + wc * 32 + fq * 8;
        bf16_t* hbase = hb + (size_t)row0 * 1024 + col0; float* sbase = ssw + (size_t)row0 * 16 + u.pn * 4 + wc;
        u32x4 r[8][2];
#pragma unroll
        for (int g = 0; g < 8; ++g) { const int rl = (g >> 2) * 128 + (g & 3) * 16;
#pragma unroll
            for (int bj = 0; bj < 2; ++bj) r[g][bj] = *(const u32x4*)(hbase + (size_t)rl * 1024 + bj * 128); }
#pragma unroll
        for (int g = 0; g < 8; ++g) { const int ai = g >> 2, m = g & 3, rl = ai * 128 + m * 16; float sq = 0.f;
#pragma unroll
            for (int bj = 0; bj < 2; ++bj) { const f32x4 v0 = unpack_lo(r[g][bj]) + acc[ai][bj][m][0] * scale, v1 = unpack_hi(r[g][bj]) + acc[ai][bj][m][1] * scale;
                *(u32x4*)(hbase + (size_t)rl * 1024 + bj * 128) = pack8(v0, v1);
                sq += ((v0[0] * v0[0] + v0[1] * v0[1]) + (v0[2] * v0[2] + v0[3] * v0[3])) + ((v1[0] * v1[0] + v1[1] * v1[1]) + (v1[2] * v1[2] + v1[3] * v1[3])); }
            sq += __shfl_xor(sq, 16); sq += __shfl_xor(sq, 32);
            if (fq == 0) sbase[(size_t)rl * 16] = sq; }
    } };
struct EpiZ { bf16_t* zA; bf16_t* sga; bf16_t* P; float* gklr; const LAS float* rs_tab; const float* gnorm;
    __device__ __forceinline__ void operator()(AccRef acc, const Unit& u, int ui, int wr, int wc, int fr, int fq) const {
        const int rl0 = wr * 64 + fr, row0 = u.pm * 256 + rl0; const int pn = u.pn; const LAS float* tab = rs_tab + ui * 256 + rl0;
        if (pn < 12) { bf16_t* base = zA + (size_t)row0 * ZLD + pn * 256 + wc * 32 + fq * 8;
#pragma unroll
            for (int ai = 0; ai < 2; ++ai)
#pragma unroll
                for (int m = 0; m < 4; ++m) { const int rl = ai * 128 + m * 16; const float rs = tab[rl];
#pragma unroll
                    for (int bj = 0; bj < 2; ++bj) *(u32x4*)(base + (size_t)rl * ZLD + bj * 128) = pack8(acc[ai][bj][m][0] * rs, acc[ai][bj][m][1] * rs); }
        } else if (pn < 16) { bf16_t* base = sga + (size_t)row0 * 1024 + (pn - 12) * 256 + wc * 32 + fq * 8;
#pragma unroll
            for (int ai = 0; ai < 2; ++ai)
#pragma unroll
                for (int m = 0; m < 4; ++m) { const int rl = ai * 128 + m * 16; const float rs = tab[rl];
#pragma unroll
                    for (int bj = 0; bj < 2; ++bj) *(u32x4*)(base + (size_t)rl * 1024 + bj * 128) = pack8(sigmoid4(acc[ai][bj][m][0] * rs), sigmoid4(acc[ai][bj][m][1] * rs)); }
        } else if (pn < 24) { const int c0 = (pn - 16) * 128 + wc * 32 + fq * 8; bf16_t* base = P + (size_t)row0 * 1024 + c0;
            const f32x4 gn0 = *(const f32x4*)(gnorm + (c0 & 255)), gn1 = *(const f32x4*)(gnorm + ((c0 + 4) & 255));
#pragma unroll
            for (int ai = 0; ai < 2; ++ai)
#pragma unroll
                for (int m = 0; m < 4; ++m) { const int rl = ai * 128 + m * 16; const float rs = tab[rl]; f32x4 o[2];
#pragma unroll
                    for (int bj = 0; bj < 2; ++bj) { const f32x4 gv = acc[ai][bj][m][0] * rs, gb = acc[ai][bj][m][1] * rs; o[bj] = sigmoid4(gb) * gv * sigmoid4(gv) * (bj ? gn1 : gn0); }
                    *(u32x4*)(base + (size_t)rl * 1024) = pack8(o[0], o[1]); }
        } else if (wc == 0 && fq < 2) {
#pragma unroll
            for (int ai = 0; ai < 2; ++ai)
#pragma unroll
                for (int m = 0; m < 4; ++m) { const int rl = ai * 128 + m * 16; const float rs = tab[rl];
                    *(f32x4*)(gklr + (size_t)(row0 + rl) * 16 + fq * 8) = acc[ai][0][m][0] * rs; *(f32x4*)(gklr + (size_t)(row0 + rl) * 16 + fq * 8 + 4) = acc[ai][0][m][1] * rs; }
        }
    } };
struct EpiMix { bf16_t* sga; const bf16_t* P; const bf16_t* o; const LAS float* rso_tab;
    __device__ __forceinline__ void operator()(AccRef acc, const Unit& u, int ui, int wr, int wc, int fr, int fq) const {
        const int rl0 = wr * 64 + fr, row0 = u.pm * 256 + rl0; const int colb = u.pn * 256 + wc * 32 + fq * 8; const LAS float* tab = rso_tab + ui * 256 + rl0;
        bf16_t* sb = sga + (size_t)row0 * 1024 + colb; const bf16_t* pb_ = P + (size_t)row0 * 1024 + colb; const bf16_t* ob = o + (size_t)row0 * ZLD + colb;
        u32x4 ro[3][2], rsg[3][2], rp[3][2];
#define MIX_LD(slot, g_) do { const int rl_ = ((g_) >> 2) * 128 + ((g_) & 3) * 16; _Pragma("unroll") for (int bj = 0; bj < 2; ++bj) { \
            ro[slot][bj] = *(const u32x4*)(ob + (size_t)rl_ * ZLD + bj * 128); rsg[slot][bj] = *(const u32x4*)(sb + (size_t)rl_ * 1024 + bj * 128); rp[slot][bj] = *(const u32x4*)(pb_ + (size_t)rl_ * 1024 + bj * 128); } } while (0)
        MIX_LD(0, 0); MIX_LD(1, 1); MIX_LD(2, 2);
#pragma unroll
        for (int g = 0; g < 8; ++g) { const int ai = g >> 2, m = g & 3, rl = ai * 128 + m * 16; const float rso = tab[rl]; u32x4 res[2];
#pragma unroll
            for (int bj = 0; bj < 2; ++bj) res[bj] = pack8(unpack_lo(rsg[g % 3][bj]) * acc[ai][bj][m][0] + unpack_lo(rp[g % 3][bj]) * (unpack_lo(ro[g % 3][bj]) * rso),
                                                           unpack_hi(rsg[g % 3][bj]) * acc[ai][bj][m][1] + unpack_hi(rp[g % 3][bj]) * (unpack_hi(ro[g % 3][bj]) * rso));
            if (g + 3 < 8) MIX_LD(g % 3, g + 3);
#pragma unroll
            for (int bj = 0; bj < 2; ++bj) *(u32x4*)(sb + (size_t)rl * 1024 + bj * 128) = res[bj];
        }
#undef MIX_LD
    } };
struct EpiBf16 { bf16_t* out;
    __device__ __forceinline__ void operator()(AccRef acc, const Unit& u, int ui, int wr, int wc, int fr, int fq) const {
        bf16_t* base = out + (size_t)(u.pm * 256 + wr * 64 + fr) * 1024 + u.pn * 256 + wc * 32 + fq * 8;
#pragma unroll
        for (int ai = 0; ai < 2; ++ai)
#pragma unroll
            for (int m = 0; m < 4; ++m)
#pragma unroll
                for (int bj = 0; bj < 2; ++bj) *(u32x4*)(base + (size_t)(ai * 128 + m * 16) * 1024 + bj * 128) = pack8(acc[ai][bj][m][0], acc[ai][bj][m][1]);
    } };
struct EpiPle { float* h; const bf16_t* hb; const bf16_t* pp; const LAS float* rs_tab; float* ssw;
    __device__ __forceinline__ void operator()(AccRef acc, const Unit& u, int ui, int wr, int wc, int fr, int fq) const {
        const int rl0 = wr * 64 + fr, row0 = u.pm * 256 + rl0, col0 = u.pn * 256 + wc * 32 + fq * 8; const LAS float* tab = rs_tab + ui * 256 + rl0;
        float* obase = h + (size_t)row0 * 1024 + col0; const bf16_t* hbase = hb + (size_t)row0 * 1024 + col0; const bf16_t* pbase = pp + (size_t)row0 * 1024 + col0; float* sbase = ssw + (size_t)row0 * 16 + u.pn * 4 + wc;
        u32x4 rh[4][2], rp[4][2];
#define PLE_LD(slot, g_) do { const int rl_ = ((g_) >> 2) * 128 + ((g_) & 3) * 16; _Pragma("unroll") for (int bj = 0; bj < 2; ++bj) { \
            rh[slot][bj] = *(const u32x4*)(hbase + (size_t)rl_ * 1024 + bj * 128); rp[slot][bj] = *(const u32x4*)(pbase + (size_t)rl_ * 1024 + bj * 128); } } while (0)
        PLE_LD(0, 0); PLE_LD(1, 1); PLE_LD(2, 2); PLE_LD(3, 3);
#pragma unroll
        for (int g = 0; g < 8; ++g) { const int ai = g >> 2, m = g & 3, rl = ai * 128 + m * 16; const float rs = tab[rl]; float sq = 0.f; f32x4 res[2][2];
#pragma unroll
            for (int bj = 0; bj < 2; ++bj) { const f32x4 v0 = unpack_lo(rh[g & 3][bj]) + sigmoid4(acc[ai][bj][m][0] * rs) * unpack_lo(rp[g & 3][bj]), v1 = unpack_hi(rh[g & 3][bj]) + sigmoid4(acc[ai][bj][m][1] * rs) * unpack_hi(rp[g & 3][bj]);
                res[bj][0] = v0; res[bj][1] = v1; sq += ((v0[0] * v0[0] + v0[1] * v0[1]) + (v0[2] * v0[2] + v0[3] * v0[3])) + ((v1[0] * v1[0] + v1[1] * v1[1]) + (v1[2] * v1[2] + v1[3] * v1[3])); }
            if (g + 4 < 8) PLE_LD(g & 3, g + 4);
#pragma unroll
            for (int bj = 0; bj < 2; ++bj) { *(f32x4*)(obase + (size_t)rl * 1024 + bj * 128) = res[bj][0]; *(f32x4*)(obase + (size_t)rl * 1024 + bj * 128 + 4) = res[bj][1]; }
            sq += __shfl_xor(sq, 16); sq += __shfl_xor(sq, 32);
            if (fq == 0) sbase[(size_t)rl * 16] = sq; }
#undef PLE_LD
    } };

struct Params { const float* in[26]; float* out; unsigned char* ws; int ph_lo, ph_hi; };

template <int MODE>
__device__ __forceinline__ void tr_item(const float* src0, const float* src1, int ldsrc, int K, bf16_t* dst, const float* gain, LAS float* scr, int item, int nblk, int lane, const float* cs = nullptr) {
    const int kb = item / nblk, nb = item % nblk, k0 = 64 * kb, n0 = 32 * nb;
    const int r8 = lane >> 3, c4 = (lane & 7) * 4; const float* sp; f32x4 sc = (f32x4){1.f, 1.f, 1.f, 1.f};
    const int lc = 8 * ((c4 >> 2) & 3) + 4 * (c4 >> 4);
    const int gq = (n0 & 255) >> 5, fi = (n0 >> 8) * 128 + (gq & 3) * 32 + ((c4 >> 2) & 3) * 8 + (gq >> 2) * 4;
    if (MODE == 0) { sp = src0 + n0 + lc; if (cs) sc = *(const f32x4*)(cs + n0 + lc); }
    else if (MODE == 1) { sp = ((c4 >> 4) ? src1 : src0) + fi; }
    else { const int n = n0 + lc;
           if (n0 < 3072) { sp = src0 + n; if (n0 >= 1024 && n0 < 1536) sc = sc * 0.08838834764831845f; }
           else if (n0 < 4096) sp = src0 + 4112 + (n - 3072);
           else if (n0 < 6144) sp = src0 + ((c4 >> 4) ? 5136 : 3088) + (fi - 2048);
           else if (n0 == 6144 && lc < 16) sp = src0 + 3072 + lc;
           else sp = nullptr; }
    f32x4 v[8];
#pragma unroll
    for (int i = 0; i < 8; ++i) { const int kk = 8 * i + r8; v[i] = sp ? __builtin_nontemporal_load((const f32x4*)(sp + (size_t)(k0 + kk) * ldsrc)) : (f32x4){0.f, 0.f, 0.f, 0.f}; }
#pragma unroll
    for (int i = 0; i < 8; ++i) { const int kk = 8 * i + r8; f32x4 t = v[i] * sc; if (gain) t = t * gain[k0 + kk];
        scr[kk * 33 + c4] = t[0]; scr[kk * 33 + c4 + 1] = t[1]; scr[kk * 33 + c4 + 2] = t[2]; scr[kk * 33 + c4 + 3] = t[3]; }
    asm volatile("s_waitcnt lgkmcnt(0)" ::: "memory");
    const int c = lane & 7;
#pragma unroll
    for (int j = 0; j < 4; ++j) { const int nn = (lane >> 3) + 8 * j; const LAS float* s_ = scr + (8 * c) * 33 + nn;
        u32x4 o; o.x = cvt_pk_bf16(s_[0 * 33], s_[1 * 33]); o.y = cvt_pk_bf16(s_[2 * 33], s_[3 * 33]); o.z = cvt_pk_bf16(s_[4 * 33], s_[5 * 33]); o.w = cvt_pk_bf16(s_[6 * 33], s_[7 * 33]);
        *(u32x4*)(dst + (size_t)(n0 + nn) * K + k0 + 8 * c) = o; }
    asm volatile("s_waitcnt lgkmcnt(0)" ::: "memory");
}
__device__ __forceinline__ void conv_ffn(const Params& p, int base, bf16_t* w1t, LAS float* scr, int gw, int NGW, int lane, int part = 0) {
    bf16_t* w2t = w1t + SZ_W1T / 2;
    constexpr int I1 = 16 * 176, I2 = 44 * 32;
    const int lo_ = (part == 2) ? I1 : 0, hi_ = (part == 1) ? I1 : I1 + I2;
    for (int it = lo_ + gw; it < hi_; it += NGW) {
        if (it < I1) tr_item<1>(p.in[base + 1], p.in[base + 2], FF, 1024, w1t, p.in[base], scr, it, 176, lane);
        else tr_item<0>(p.in[base + 3], nullptr, 1024, FF, w2t, nullptr, scr, it - I1, 32, lane);
    }
}
constexpr size_t Y_FFN2_OFF = (size_t)33 * MiB;
__device__ __forceinline__ void conv_rest(const Params& p, LAS unsigned char* lds, int gw, int NGW) {
    const int tid = threadIdx.x, lane = tid & 63, wave = tid >> 6; LAS float* scr = (LAS float*)(lds + wave * 16384); unsigned char* ws = p.ws;
    constexpr int I_IN = 16 * 200, I_POOL = 4 * 4 * 8, I_OUT = 16 * 32, I_PG = 16 * 32, I_PP = 4 * 32;
    for (int it = gw; it < I_IN + I_POOL + I_OUT + I_PG + I_PP; it += NGW) {
        int r = it;
        if (r < I_IN) { tr_item<2>(p.in[11], nullptr, WIN_LD, 1024, (bf16_t*)(ws + OFF_WIN), p.in[10], scr, r, 200, lane); continue; } r -= I_IN;
        if (r < I_POOL) { const int g = r >> 5; tr_item<0>(p.in[15] + (size_t)g * 65536, nullptr, 256, 256, (bf16_t*)(ws + OFF_WPT) + (size_t)g * 65536, nullptr, scr, r & 31, 8, lane, p.in[16] + g * 256); continue; } r -= I_POOL;
        if (r < I_OUT) { tr_item<0>(p.in[17], nullptr, 1024, 1024, (bf16_t*)(ws + OFF_WOUT), nullptr, scr, r, 32, lane); continue; } r -= I_OUT;
        if (r < I_PG) { tr_item<0>(p.in[23], nullptr, 1024, 1024, (bf16_t*)(ws + OFF_WPG), p.in[22], scr, r, 32, lane); continue; } r -= I_PG;
        tr_item<0>(p.in[24], nullptr, 1024, 256, (bf16_t*)(ws + OFF_WPP), nullptr, scr, r, 32, lane);
    }
}
__device__ __forceinline__ void phase_prep(const Params& p, LAS unsigned char* lds) {
    const int tid = threadIdx.x, lane = tid & 63, wave = tid >> 6; const int gw = blockIdx.x * 8 + wave, NGW = gridDim.x * 8;
    LAS float* scr = (LAS float*)(lds + wave * 16384);
    unsigned char* ws = p.ws;
    conv_ffn(p, 6, (bf16_t*)(ws + OFF_WFFN), scr, gw, NGW, lane);
    bf16_t* xb = (bf16_t*)(ws + OFF_HB); float* ssa = (float*)(ws + OFF_SSA); bf16_t* pb = (bf16_t*)(ws + OFF_PB);
    for (int row0 = gw; row0 < M; row0 += 2 * NGW) {
        f32x4 v[2][4], pv[2]; float sx[2];
#pragma unroll
        for (int e = 0; e < 2; ++e) { const int row = row0 + e * NGW; if (row < M) {
            const float* xr = (row < MP) ? p.in[0] + (size_t)row * 1024 : p.in[1] + (size_t)(row - MP) * 1024;
            const float* pr = (row < MP) ? p.in[2] + (size_t)row * 256 : p.in[3] + (size_t)(row - MP) * 256;
#pragma unroll
            for (int j = 0; j < 4; ++j) v[e][j] = __builtin_nontemporal_load((const f32x4*)(xr + j * 256 + lane * 4));
            pv[e] = __builtin_nontemporal_load((const f32x4*)(pr + lane * 4)); } }
#pragma unroll
        for (int e = 0; e < 2; ++e) { const int row = row0 + e * NGW; if (row < M) { float s_ = 0.f;
#pragma unroll
            for (int j = 0; j < 4; ++j) s_ += (v[e][j][0] * v[e][j][0] + v[e][j][1] * v[e][j][1]) + (v[e][j][2] * v[e][j][2] + v[e][j][3] * v[e][j][3]);
            sx[e] = wave_sum(s_);
#pragma unroll
            for (int j = 0; j < 4; ++j) *(u32x2*)(xb + (size_t)row * 1024 + j * 256 + lane * 4) = pack4(v[e][j]);
            if (lane < 16) ssa[(size_t)row * 16 + lane] = (lane == 0) ? sx[e] : 0.f;
            *(u32x2*)(pb + (size_t)row * 256 + lane * 4) = pack4(pv[e]); } }
    }
}

__device__ __forceinline__ float logsig16(float x) { return (fminf(x, 0.f) - __logf(1.0f + __expf(-fabsf(x)))) * 0.0625f; }
struct PrepPf { f32x4 gk; u32x4 v[4], q[2], k[2]; };
__device__ __forceinline__ void prep_prefetch(const Params& p, int item, PrepPf& pf) {
    const bf16_t* zA = (const bf16_t*)(p.ws + OFF_BIG); const float* gklr = (const float*)(p.ws + OFF_GKLR);
    const int b = item >> 7, n = (item >> 2) & 31, h = item & 3, r0 = b * 2048 + n * 64, tid = threadIdx.x;
    pf.gk = (f32x4){0.f, 0.f, 0.f, 0.f};
    if (tid < 256) pf.gk = *(const f32x4*)(gklr + (size_t)r0 * 16 + tid * 4);
#pragma unroll
    for (int x = 0; x < 4; ++x) { const int q = tid + 512 * x, row = q >> 5, cc = q & 31; pf.v[x] = *(const u32x4*)(zA + (size_t)(r0 + row) * ZLD + 2048 + h * 256 + cc * 8); }
#pragma unroll
    for (int x = 0; x < 2; ++x) { const int q = tid + 512 * x, row = q >> 4, cc = q & 15;
        pf.q[x] = *(const u32x4*)(zA + (size_t)(r0 + row) * ZLD + 1024 + h * 128 + cc * 8); pf.k[x] = *(const u32x4*)(zA + (size_t)(r0 + row) * ZLD + 1536 + h * 128 + cc * 8); }
}
__device__ __forceinline__ void gla_prep_item(const Params& p, LAS unsigned char* lds, int item, PrepPf& pf, int next_item) {
    unsigned char* ws = p.ws; bf16_t* zA = (bf16_t*)(ws + OFF_BIG);
    bf16_t* At = (bf16_t*)(ws + OFF_AT); float* decl = (float*)(ws + OFF_DECL);
    const int b = item >> 7, n = (item >> 2) & 31, h = item & 3, r0 = b * 2048 + n * 64;
    const int tid = threadIdx.x, cch = tid & 127, jq = tid >> 7, lane = tid & 63, wave = tid >> 6, fr = lane & 15, fq = lane >> 4;
    LAS float* gk_l = (LAS float*)lds; LAS float* tot = (LAS float*)(lds + 4096);
    LAS bf16_t* QL = (LAS bf16_t*)(lds + 6144); LAS bf16_t* KL = (LAS bf16_t*)(lds + 23552); LAS bf16_t* VL = (LAS bf16_t*)(lds + 40960);
    if (tid < 256) *(LAS f32x4*)(gk_l + tid * 4) = pf.gk;
#pragma unroll
    for (int x = 0; x < 4; ++x) { const int q = tid + 512 * x, row = q >> 5, cc = q & 31; *(LAS u32x4*)(VL + row * 264 + cc * 8) = pf.v[x]; }
#pragma unroll
    for (int x = 0; x < 2; ++x) { const int q = tid + 512 * x, row = q >> 4, cc = q & 15; *(LAS u32x4*)(QL + row * 136 + cc * 8) = pf.q[x]; *(LAS u32x4*)(KL + row * 136 + cc * 8) = pf.k[x]; }
    float bl[16]; float run = 0.f;
    { float wup[16];
#pragma unroll
      for (int i = 0; i < 16; ++i) wup[i] = p.in[12][i * 512 + h * 128 + cch];
      const float bg = p.in[13][h * 128 + cch];
      asm volatile("s_waitcnt vmcnt(0) lgkmcnt(0)" ::: "memory");
      __syncthreads();
#pragma unroll
      for (int i = 0; i < 16; ++i) { const int j = jq * 16 + i; float x = bg;
#pragma unroll
        for (int r = 0; r < 16; ++r) x += gk_l[j * 16 + r] * wup[r];
        run += logsig16(x); bl[i] = run; } }
    tot[jq * 128 + cch] = run;
    __syncthreads();
    float pre = 0.f, blast = 0.f;
#pragma unroll
    for (int q = 0; q < 4; ++q) { const float t = tot[q * 128 + cch]; blast += t; if (q < jq) pre += t; }
    unsigned kd[8];
#pragma unroll
    for (int i = 0; i < 16; i += 2) { float kdv[2];
#pragma unroll
        for (int e = 0; e < 2; ++e) { const int ii = i + e, j = jq * 16 + ii; const float bb = bl[ii] + pre; const float qraw = bf1(QL[j * 136 + cch]), kraw = bf1(KL[j * 136 + cch]);
            const float qt = qraw * __expf(bb), kt = kraw * __expf(-bb); kdv[e] = kraw * __expf(blast - bb);
            QL[j * 136 + cch] = f2bf(qt); KL[j * 136 + cch] = f2bf(kt); }
        kd[i >> 1] = cvt_pk_bf16(kdv[0], kdv[1]); }
    if (jq == 0) decl[(size_t)item * 128 + cch] = __expf(blast);
    { bf16_t* dst = zA + (size_t)(r0 + (cch >> 1)) * ZLD + 1536 + h * 128 + (cch & 1) * 64 + jq * 16;
      *(u32x4*)dst = (u32x4){kd[0], kd[1], kd[2], kd[3]}; *(u32x4*)(dst + 8) = (u32x4){kd[4], kd[5], kd[6], kd[7]}; }
    __syncthreads();
#pragma unroll
    for (int x = 0; x < 2; ++x) { const int q = tid + 512 * x, row = q >> 4, cc = q & 15;
        *(u32x4*)(zA + (size_t)(r0 + row) * ZLD + 1024 + h * 128 + cc * 8) = *(const LAS u32x4*)(QL + row * 136 + cc * 8); }
    { const int tt = wave >> 1;
#pragma unroll
      for (int x = 0; x < 2; ++x) { const int jt = (wave & 1) * 2 + x; f32x4 a = (f32x4){0.f, 0.f, 0.f, 0.f};
        if (jt <= tt) {
#pragma unroll
            for (int ks = 0; ks < 4; ++ks) { const bf16x8 xk = *(const LAS bf16x8*)(KL + (16 * jt + fr) * 136 + 32 * ks + 8 * fq), yq = *(const LAS bf16x8*)(QL + (16 * tt + fr) * 136 + 32 * ks + 8 * fq);
                a = __builtin_amdgcn_mfma_f32_16x16x32_bf16(xk, yq, a, 0, 0, 0); } }
        const int t = 16 * tt + fr, j0 = 16 * jt + 4 * fq;
#pragma unroll
        for (int r = 0; r < 4; ++r) if (j0 + r > t) a[r] = 0.f;
        *(u32x2*)(At + (size_t)item * 4096 + t * 64 + j0) = pack4(a); } }
#pragma unroll
    for (int x = 0; x < 2; ++x) { const int pi = tid + 512 * x, vv = pi >> 2, j2 = pi & 3; unsigned w[8];
#pragma unroll
        for (int i = 0; i < 8; ++i) { const unsigned lo = VL[(j2 * 16 + 2 * i) * 264 + vv], hi = VL[(j2 * 16 + 2 * i + 1) * 264 + vv]; w[i] = lo | (hi << 16); }
        bf16_t* dst = zA + (size_t)(r0 + (vv >> 2)) * ZLD + 2048 + h * 256 + (vv & 3) * 64 + j2 * 16;
        *(u32x4*)dst = (u32x4){w[0], w[1], w[2], w[3]}; *(u32x4*)(dst + 8) = (u32x4){w[4], w[5], w[6], w[7]}; }
    if (next_item >= 0) prep_prefetch(p, next_item, pf);
    __syncthreads();
}
template <int W>
__device__ __forceinline__ void pool_tile(const bf16_t* zA, bf16_t* pooled, size_t rb, int t0, int c0) {
    unsigned prev[16], cur[16];
#pragma unroll
    for (int i = 0; i < 16; ++i) { const int tt = t0 - 16 + i; prev[i] = (tt >= 0) ? *(const unsigned*)(zA + (rb + tt) * ZLD + c0) : 0u; }
    float s0 = 0.f, s1 = 0.f;
#pragma unroll
    for (int i = 17 - W; i < 16; ++i) { s0 += bf_lo(prev[i]); s1 += bf_hi(prev[i]); }
#pragma unroll 1
    for (int blk = 0; blk < 4; ++blk) { const int tb = t0 + blk * 16;
#pragma unroll
        for (int i = 0; i < 16; ++i) cur[i] = *(const unsigned*)(zA + (rb + tb + i) * ZLD + c0);
#pragma unroll
        for (int i = 0; i < 16; ++i) { const float u0 = bf_lo(cur[i]), u1 = bf_hi(cur[i]); s0 += u0; s1 += u1; const int t = tb + i;
            const float ic = 1.0f / (float)((t + 1 < W) ? (t + 1) : W);
            *(unsigned*)(pooled + (rb + t) * 1024 + c0) = cvt_pk_bf16(s0 * ic - u0, s1 * ic - u1);
            const int k = i - W + 1; const unsigned d = (k >= 0) ? cur[k >= 0 ? k : 0] : prev[k >= 0 ? 0 : 16 + k]; s0 -= bf_lo(d); s1 -= bf_hi(d); }
#pragma unroll
        for (int i = 0; i < 16; ++i) prev[i] = cur[i]; }
}
__device__ __forceinline__ void pool_prompt_item(const Params& p, int item) {
    unsigned char* ws = p.ws; const bf16_t* zA = (const bf16_t*)(ws + OFF_BIG); bf16_t* pooled = (bf16_t*)p.out;
    const int b = item >> 5, n = item & 31, tid = threadIdx.x, c0 = 2 * tid, g = c0 >> 8, t0 = n * 64; const size_t rb = (size_t)b * 2048;
    if (g == 0) pool_tile<2>(zA, pooled, rb, t0, c0); else if (g == 1) pool_tile<4>(zA, pooled, rb, t0, c0); else if (g == 2) pool_tile<8>(zA, pooled, rb, t0, c0); else pool_tile<16>(zA, pooled, rb, t0, c0);
    if (n == 31) { float* np = p.out + OUT_NPP + (size_t)b * 15 * 1024;
#pragma unroll
        for (int i = 0; i < 15; ++i) { const unsigned v = *(const unsigned*)(zA + (rb + 2033 + i) * ZLD + c0); *(f32x2*)(np + i * 1024 + c0) = (f32x2){bf_lo(v), bf_hi(v)}; } }
}
template <int W>
__device__ __forceinline__ void pool_sample_w(const float (&e0)[19], const float (&e1)[19], bf16_t* prow, int c0) {
#pragma unroll
    for (int t = 0; t < 4; ++t) { float s0 = 0.f, s1 = 0.f;
#pragma unroll
        for (int r = 15 + t - W + 1; r <= 15 + t; ++r) { s0 += e0[r]; s1 += e1[r]; }
        *(unsigned*)(prow + (size_t)t * 1024 + c0) = cvt_pk_bf16(s0 * (1.0f / W) - e0[15 + t], s1 * (1.0f / W) - e1[15 + t]); }
}
__device__ __forceinline__ void pool_sample_item(const Params& p, int b) {
    unsigned char* ws = p.ws; const bf16_t* zA = (const bf16_t*)(ws + OFF_BIG); bf16_t* pooled = (bf16_t*)p.out;
    const int tid = threadIdx.x, c0 = 2 * tid, g = c0 >> 8; const float* sp = p.in[4] + (size_t)b * 15 * 1024; const size_t r0 = (size_t)MP + b * 4;
    float e0[19], e1[19];
#pragma unroll
    for (int r = 0; r < 15; ++r) { const f32x2 v = __builtin_nontemporal_load((const f32x2*)(sp + r * 1024 + c0)); e0[r] = v[0]; e1[r] = v[1]; }
#pragma unroll
    for (int t = 0; t < 4; ++t) { const unsigned v = *(const unsigned*)(zA + (r0 + t) * ZLD + c0); e0[15 + t] = bf_lo(v); e1[15 + t] = bf_hi(v); }
    bf16_t* prow = pooled + r0 * 1024;
    if (g == 0) pool_sample_w<2>(e0, e1, prow, c0); else if (g == 1) pool_sample_w<4>(e0, e1, prow, c0); else if (g == 2) pool_sample_w<8>(e0, e1, prow, c0); else pool_sample_w<16>(e0, e1, prow, c0);
    float* np = p.out + OUT_NPS + (size_t)b * 15 * 1024;
#pragma unroll
    for (int i = 0; i < 15; ++i) *(f32x2*)(np + i * 1024 + c0) = (f32x2){e0[i + 4], e1[i + 4]};
}

constexpr int RB_Q = 0, RB_K = 17408, RB_A = 35840, RB_V = 45056, RB_D = 63488, RB_SZ = 65536;
__device__ __forceinline__ void gla_rec_item(const Params& p, LAS unsigned char* lds, int item) {
    unsigned char* ws = p.ws; bf16_t* zA = (bf16_t*)(ws + OFF_BIG); const bf16_t* At = (const bf16_t*)(ws + OFF_AT); const float* decl = (const float*)(ws + OFF_DECL); float* oss = (float*)(ws + OFF_OSS);
    const int quarter = item & 3, h = (item >> 2) & 3, b = item >> 4;
    const int tid = threadIdx.x, lane = tid & 63, wave = tid >> 6, fr = lane & 15, fq = lane >> 4;
    f32x4 S[8];
#pragma unroll
    for (int i = 0; i < 8; ++i) S[i] = (f32x4){0.f, 0.f, 0.f, 0.f};
    u32x4 rqA[2], rkA[2], raA, rvA, rqB[2], rkB[2], raB, rvB; f32x4 rdA = (f32x4){0.f, 0.f, 0.f, 0.f}, rdB = (f32x4){0.f, 0.f, 0.f, 0.f};
#define REC_LOAD(T, nn) do { const int r0_ = b * 2048 + (nn) * 64; const size_t it_ = (size_t)((b * 32 + (nn)) * 4 + h); \
        _Pragma("unroll") for (int x = 0; x < 2; ++x) { const int id = tid + 512 * x; \
            rq##T[x] = *(const u32x4*)(zA + (size_t)(r0_ + (id >> 4)) * ZLD + 1024 + h * 128 + (id & 15) * 8); \
            rk##T[x] = *(const u32x4*)(zA + (size_t)(r0_ + (id >> 4)) * ZLD + 1536 + h * 128 + (id & 15) * 8); \
            } \
        rv##T = *(const u32x4*)(zA + (size_t)(r0_ + 16 * quarter + (tid >> 5)) * ZLD + 2048 + h * 256 + (tid & 31) * 8); \
        ra##T = *(const u32x4*)(At + it_ * 4096 + (tid >> 3) * 64 + (tid & 7) * 8); \
        if (tid < 32) rd##T = *(const f32x4*)(decl + it_ * 128 + tid * 4); } while (0)
#define REC_STORE(T, buf) do { LAS unsigned char* B_ = lds + (buf) * RB_SZ; \
        _Pragma("unroll") for (int x = 0; x < 2; ++x) { const int id = tid + 512 * x; \
            *(LAS u32x4*)(B_ + RB_Q + (id >> 4) * 272 + (id & 15) * 16) = rq##T[x]; \
            *(LAS u32x4*)(B_ + RB_K + (2 * (id >> 4) + ((id & 15) >> 3)) * 144 + (id & 7) * 16) = rk##T[x]; \
            } \
        *(LAS u32x4*)(B_ + RB_V + (4 * (tid >> 5) + ((tid & 31) >> 3)) * 144 + (tid & 7) * 16) = rv##T; \
        *(LAS u32x4*)(B_ + RB_A + (tid >> 3) * 144 + (tid & 7) * 16) = ra##T; \
        if (tid < 32) *(LAS f32x4*)(B_ + RB_D + tid * 16) = rd##T; } while (0)
#define REC_STEP(n) do { \
        const LAS unsigned char* B = lds + ((n) & 1) * RB_SZ; const int r0 = b * 2048 + (n) * 64; \
        bf16x8 vt[2]; u32x2 qf[4][4][2]; bf16x8 af[4][2]; \
        _Pragma("unroll") for (int jk = 0; jk < 2; ++jk) vt[jk] = *(const LAS bf16x8*)(B + RB_V + (16 * wave + fr) * 144 + (32 * jk + 8 * fq) * 2); \
        _Pragma("unroll") for (int tt = 0; tt < 4; ++tt) { \
            _Pragma("unroll") for (int cp = 0; cp < 4; ++cp) { const LAS unsigned char* qa = B + RB_Q + (16 * tt + fr) * 272 + (32 * cp + 4 * fq) * 2; qf[tt][cp][0] = *(const LAS u32x2*)qa; qf[tt][cp][1] = *(const LAS u32x2*)(qa + 32); } \
            _Pragma("unroll") for (int jk = 0; jk < 2; ++jk) af[tt][jk] = *(const LAS bf16x8*)(B + RB_A + (16 * tt + fr) * 144 + (32 * jk + 8 * fq) * 2); } \
        bf16x8 sop[4]; \
        _Pragma("unroll") for (int cp = 0; cp < 4; ++cp) { u32x4 w; w.x = cvt_pk_bf16(S[2 * cp][0], S[2 * cp][1]); w.y = cvt_pk_bf16(S[2 * cp][2], S[2 * cp][3]); w.z = cvt_pk_bf16(S[2 * cp + 1][0], S[2 * cp + 1][1]); w.w = cvt_pk_bf16(S[2 * cp + 1][2], S[2 * cp + 1][3]); \
            sop[cp] = __builtin_bit_cast(bf16x8, w); } \
        f32x4 o[4]; \
        _Pragma("unroll") for (int tt = 0; tt < 4; ++tt) o[tt] = (f32x4){0.f, 0.f, 0.f, 0.f}; \
        _Pragma("unroll") for (int cp = 0; cp < 4; ++cp) \
            _Pragma("unroll") for (int tt = 0; tt < 4; ++tt) { const u32x4 qw = (u32x4){qf[tt][cp][0].x, qf[tt][cp][0].y, qf[tt][cp][1].x, qf[tt][cp][1].y}; \
                o[tt] = __builtin_amdgcn_mfma_f32_16x16x32_bf16(sop[cp], __builtin_bit_cast(bf16x8, qw), o[tt], 0, 0, 0); } \
        _Pragma("unroll") for (int jk = 0; jk < 2; ++jk) \
            _Pragma("unroll") for (int tt = 0; tt < 4; ++tt) o[tt] = __builtin_amdgcn_mfma_f32_16x16x32_bf16(vt[jk], af[tt][jk], o[tt], 0, 0, 0); \
        __builtin_amdgcn_sched_barrier(0); \
        _Pragma("unroll") for (int tt = 0; tt < 4; ++tt) { const int row = r0 + 16 * tt + fr; \
            *(u32x2*)(zA + (size_t)row * ZLD + h * 256 + quarter * 64 + wave * 16 + 4 * fq) = pack4(o[tt]); \
            float sq = (o[tt][0] * o[tt][0] + o[tt][1] * o[tt][1]) + (o[tt][2] * o[tt][2] + o[tt][3] * o[tt][3]); sq += __shfl_xor(sq, 16); sq += __shfl_xor(sq, 32); \
            if (fq == 0) oss[(size_t)row * 64 + h * 16 + quarter * 4 + wave] = sq; } \
        _Pragma("unroll") for (int hf = 0; hf < 2; ++hf) { bf16x8 kf[4][2]; f32x4 dv[4]; \
            _Pragma("unroll") for (int c4 = 0; c4 < 4; ++c4) { const int ct = hf * 4 + c4; dv[c4] = *(const LAS f32x4*)(B + RB_D + (16 * ct + 4 * fq) * 4); \
                _Pragma("unroll") for (int jk = 0; jk < 2; ++jk) kf[c4][jk] = *(const LAS bf16x8*)(B + RB_K + (16 * ct + fr) * 144 + (32 * jk + 8 * fq) * 2); } \
            _Pragma("unroll") for (int c4 = 0; c4 < 4; ++c4) S[hf * 4 + c4] = S[hf * 4 + c4] * dv[c4]; \
            _Pragma("unroll") for (int jk = 0; jk < 2; ++jk) \
                _Pragma("unroll") for (int c4 = 0; c4 < 4; ++c4) S[hf * 4 + c4] = __builtin_amdgcn_mfma_f32_16x16x32_bf16(kf[c4][jk], vt[jk], S[hf * 4 + c4], 0, 0, 0); \
            __builtin_amdgcn_sched_barrier(0); } \
        } while (0)
    REC_LOAD(A, 0); REC_STORE(A, 0); REC_LOAD(B, 1);
    __syncthreads();
#pragma unroll 1
    for (int n = 0; n < 32; n += 2) {
        if (n + 2 < 32) REC_LOAD(A, n + 2);
        if (wave < 4) REC_STEP(n);
        REC_STORE(B, 1);
        __syncthreads();
        if (n + 3 < 32) REC_LOAD(B, n + 3);
        if (wave < 4) REC_STEP(n + 1);
        if (n + 2 < 32) REC_STORE(A, 0);
        __syncthreads();
    }
#undef REC_LOAD
#undef REC_STORE
#undef REC_STEP
    if (wave >= 4) return;
    float* so = p.out + OUT_NGP + (size_t)(b * 4 + h) * 128 * 256 + quarter * 64 + wave * 16 + fr;
#pragma unroll
    for (int ct = 0; ct < 8; ++ct)
#pragma unroll
        for (int r = 0; r < 4; ++r) so[(size_t)(16 * ct + 4 * fq + r) * 256] = S[ct][r];
}
__device__ __forceinline__ void gla_sample_item(const Params& p, LAS unsigned char* lds, int item) {
    unsigned char* ws = p.ws; bf16_t* zA = (bf16_t*)(ws + OFF_BIG); const float* gklr = (const float*)(ws + OFF_GKLR); float* oss = (float*)(ws + OFF_OSS);
    const int b = item >> 2, h = item & 3, r0 = MP + b * 4; const int tid = threadIdx.x, lane = tid & 63, wave = tid >> 6;
    LAS float* qe = (LAS float*)lds;
    LAS float* ke = qe + 512;
    LAS float* dl = ke + 512;
    LAS float* Ap = dl + 128;
    LAS float* vl = Ap + 32;
    LAS float* op = vl + 1024;
    for (int i = tid; i < 1024; i += 512) vl[i] = bf1(zA[(size_t)(r0 + (i >> 8)) * ZLD + 2048 + h * 256 + (i & 255)]);
    LAS float* gkl = op;
    if (tid >= 448) gkl[tid - 448] = gklr[(size_t)r0 * 16 + (tid - 448)];
    __syncthreads();
    if (tid < 128) { const int c = tid; float bl[4], qv[4], kv[4]; float run = 0.f; const float bg = p.in[13][h * 128 + c];
        float wup[16];
#pragma unroll
        for (int r = 0; r < 16; ++r) wup[r] = p.in[12][r * 512 + h * 128 + c];
#pragma unroll
        for (int t = 0; t < 4; ++t) { float x = bg;
#pragma unroll
            for (int r = 0; r < 16; ++r) x += gkl[t * 16 + r] * wup[r];
            run += logsig16(x); bl[t] = run; qv[t] = bf1(zA[(size_t)(r0 + t) * ZLD + 1024 + h * 128 + c]); kv[t] = bf1(zA[(size_t)(r0 + t) * ZLD + 1536 + h * 128 + c]); }
#pragma unroll
        for (int t = 0; t < 4; ++t) { qe[t * 128 + c] = qv[t] * __expf(bl[t]); ke[t * 128 + c] = kv[t] * __expf(bl[3] - bl[t]); }
        dl[c] = __expf(bl[3]);
#pragma unroll
        for (int i = 0; i < 4; ++i)
#pragma unroll
            for (int j = 0; j < 4; ++j) { float v = (j <= i) ? qv[i] * kv[j] * __expf(bl[i] - bl[j]) : 0.f; v = wave_sum(v); if (lane == 0) Ap[wave * 16 + i * 4 + j] = v; }
    }
    __syncthreads();
    const int vq = tid & 63, cp = tid >> 6;
    const float* S0 = p.in[5] + (size_t)item * 128 * 256; float* Sn = p.out + OUT_NGS + (size_t)item * 128 * 256;
    f32x4 vv[4];
#pragma unroll
    for (int j = 0; j < 4; ++j) vv[j] = *(const LAS f32x4*)(vl + j * 256 + vq * 4);
    f32x4 oa[4];
#pragma unroll
    for (int i = 0; i < 4; ++i) oa[i] = (f32x4){0.f, 0.f, 0.f, 0.f};
#pragma unroll 1
    for (int c8 = 0; c8 < 2; ++c8) {
    f32x4 s0r[8];
#pragma unroll
    for (int cc = 0; cc < 8; ++cc) s0r[cc] = __builtin_nontemporal_load((const f32x4*)(S0 + (size_t)(cp * 16 + c8 * 8 + cc) * 256 + vq * 4));
#pragma unroll
    for (int cc = 0; cc < 8; ++cc) { const int c = cp * 16 + c8 * 8 + cc; const f32x4 s = s0r[cc];
        f32x4 sn = s * dl[c];
#pragma unroll
        for (int j = 0; j < 4; ++j) sn += vv[j] * ke[j * 128 + c];
        *(f32x4*)(Sn + (size_t)c * 256 + vq * 4) = sn;
#pragma unroll
        for (int i = 0; i < 4; ++i) oa[i] += s * qe[i * 128 + c]; }
    }
#pragma unroll
    for (int i = 0; i < 4; ++i) *(LAS f32x4*)(op + (cp * 4 + i) * 256 + vq * 4) = oa[i];
    __syncthreads();
    if (tid < 256) { const int i = tid >> 6; f32x4 o = (f32x4){0.f, 0.f, 0.f, 0.f};
#pragma unroll
        for (int q = 0; q < 8; ++q) o += *(const LAS f32x4*)(op + (q * 4 + i) * 256 + vq * 4);
#pragma unroll
        for (int j = 0; j < 4; ++j) if (j <= i) o += vv[j] * (Ap[i * 4 + j] + Ap[16 + i * 4 + j]);
        *(u32x2*)(zA + (size_t)(r0 + i) * ZLD + h * 256 + vq * 4) = pack4(o);
        float sq = (o[0] * o[0] + o[1] * o[1]) + (o[2] * o[2] + o[3] * o[3]); sq = wave_sum(sq);
        if (lane < 16) oss[(size_t)(r0 + i) * 64 + h * 16 + lane] = (lane == 0) ? sq : 0.f; }
    __syncthreads();
}

__device__ __forceinline__ void conv_ffn2_idle(const Params& p, LAS unsigned char* lds, int G, int bid, int part, int nbusy) {
    if (bid < nbusy) return;
    const int tid = threadIdx.x; conv_ffn(p, 18, (bf16_t*)((unsigned char*)p.out + Y_FFN2_OFF), (LAS float*)(lds + (tid >> 6) * 16384), (bid - nbusy) * 8 + (tid >> 6), (G - nbusy) * 8, tid & 63, part);
}


template <class SE>
__device__ __forceinline__ void sample_gemm(const bf16_t* A, int lda, int a_pn_off, const bf16_t* Bt, int ldb, int K, int piece, const SE& E, LAS unsigned char* lds) {
    const int tid = threadIdx.x, lane = tid & 63, w8 = tid >> 6, w = w8 & 3, kh = w8 >> 2, mi = w >> 1, gi = w & 1, fr = lane & 15, fq = lane >> 4;
    const int mt2 = piece >> 4, cch = piece & 15, pn = cch >> 2, grp = 2 * (cch & 3) + gi;
    const int row = MP + 32 * mt2 + 16 * mi + fr, Kh = K >> 1;
    const bf16_t* ap = A + (size_t)row * lda + pn * a_pn_off + kh * Kh + 8 * fq;
    const bf16_t* bp0 = Bt + (size_t)(256 * pn + 32 * grp + fr) * ldb + kh * Kh + 8 * fq; const bf16_t* bp1 = bp0 + (size_t)16 * ldb;
    f32x4 acc0 = (f32x4){0.f, 0.f, 0.f, 0.f}, acc1 = (f32x4){0.f, 0.f, 0.f, 0.f};
    bf16x8 aA[4], b0A[4], b1A[4], aB[4], b0B[4], b1B[4];
#define SG_LD(T, kk) do { _Pragma("unroll") for (int j = 0; j < 4; ++j) { a##T[j] = *(const bf16x8*)(ap + (kk) + 32 * j); b0##T[j] = *(const bf16x8*)(bp0 + (kk) + 32 * j); b1##T[j] = *(const bf16x8*)(bp1 + (kk) + 32 * j); } } while (0)
#define SG_MM(T) do { _Pragma("unroll") for (int j = 0; j < 4; ++j) { acc0 = __builtin_amdgcn_mfma_f32_16x16x32_bf16(b0##T[j], a##T[j], acc0, 0, 0, 0); acc1 = __builtin_amdgcn_mfma_f32_16x16x32_bf16(b1##T[j], a##T[j], acc1, 0, 0, 0); } } while (0)
    SG_LD(A, 0);
#pragma unroll 1
    for (int k = 0; k < Kh; k += 256) {
        if (k + 128 < Kh) SG_LD(B, k + 128);
        SG_MM(A);
        if (k + 256 < Kh) SG_LD(A, k + 256);
        if (k + 128 < Kh) SG_MM(B);
    }
#undef SG_LD
#undef SG_MM
    LAS f32x4* xch = (LAS f32x4*)(lds + 4096);
    __syncthreads();
    if (kh == 1) { xch[(w * 64 + lane) * 2] = acc0; xch[(w * 64 + lane) * 2 + 1] = acc1; }
    __syncthreads();
    if (kh == 0) { acc0 += xch[(w * 64 + lane) * 2]; acc1 += xch[(w * 64 + lane) * 2 + 1]; }
    E(kh == 0, row, 256 * pn + 32 * grp + 8 * fq, pn, cch & 3, w, fr, fq, acc0, acc1, lds);
}
__device__ __forceinline__ void sample_ss(bool act, float sq, int row, int pn, int slot, int w, int fr, int fq, float* ssw, LAS unsigned char* lds) {
    LAS float* t = (LAS float*)lds; sq += __shfl_xor(sq, 16); sq += __shfl_xor(sq, 32);
    __syncthreads();
    if (act && fq == 0) t[w * 16 + fr] = sq;
    __syncthreads();
    if (act && fq == 0 && (w & 1) == 0) ssw[(size_t)row * 16 + pn * 4 + slot] = t[w * 16 + fr] + t[(w + 1) * 16 + fr];
}
struct SEpiResid { bf16_t* hb; float* ssw; float scale;
    __device__ __forceinline__ void operator()(bool act, int row, int c0, int pn, int slot, int w, int fr, int fq, f32x4 a0, f32x4 a1, LAS unsigned char* lds) const {
        bf16_t* hp = hb + (size_t)row * 1024 + c0; f32x4 v0 = (f32x4){0.f, 0.f, 0.f, 0.f}, v1 = v0;
        if (act) { const u32x4 r = *(const u32x4*)hp; v0 = unpack_lo(r) + a0 * scale; v1 = unpack_hi(r) + a1 * scale; *(u32x4*)hp = pack8(v0, v1); }
        sample_ss(act, ((v0[0] * v0[0] + v0[1] * v0[1]) + (v0[2] * v0[2] + v0[3] * v0[3])) + ((v1[0] * v1[0] + v1[1] * v1[1]) + (v1[2] * v1[2] + v1[3] * v1[3])), row, pn, slot, w, fr, fq, ssw, lds);
    } };
struct SEpiMix { bf16_t* sga; const bf16_t* P; const bf16_t* o; const float* oss;
    __device__ __forceinline__ void operator()(bool act, int row, int c0, int pn, int slot, int w, int fr, int fq, f32x4 a0, f32x4 a1, LAS unsigned char* lds) const {
        if (!act) return;
        const float rso = 1.0f / sqrtf(sum16(oss + (size_t)row * 64 + pn * 16) * (1.0f / 256.0f) + EPS);
        bf16_t* sp = sga + (size_t)row * 1024 + c0; const u32x4 sg = *(const u32x4*)sp, pv = *(const u32x4*)(P + (size_t)row * 1024 + c0), ov = *(const u32x4*)(o + (size_t)row * ZLD + c0);
        *(u32x4*)sp = pack8(unpack_lo(sg) * a0 + unpack_lo(pv) * (unpack_lo(ov) * rso), unpack_hi(sg) * a1 + unpack_hi(pv) * (unpack_hi(ov) * rso));
    } };
struct SEpiBf16 { bf16_t* out;
    __device__ __forceinline__ void operator()(bool act, int row, int c0, int pn, int slot, int w, int fr, int fq, f32x4 a0, f32x4 a1, LAS unsigned char* lds) const { if (act) *(u32x4*)(out + (size_t)row * 1024 + c0) = pack8(a0, a1); } };
struct SEpiPle { float* h; const bf16_t* hb; const bf16_t* pp; const float* ss; float* ssw;
    __device__ __forceinline__ void operator()(bool act, int row, int c0, int pn, int slot, int w, int fr, int fq, f32x4 a0, f32x4 a1, LAS unsigned char* lds) const {
        f32x4 v0 = (f32x4){0.f, 0.f, 0.f, 0.f}, v1 = v0;
        if (act) { const float rs = rowscale(ss, row, 1.0f / 1024.0f); const u32x4 hv = *(const u32x4*)(hb + (size_t)row * 1024 + c0), pv = *(const u32x4*)(pp + (size_t)row * 1024 + c0);
            v0 = unpack_lo(hv) + sigmoid4(a0 * rs) * unpack_lo(pv); v1 = unpack_hi(hv) + sigmoid4(a1 * rs) * unpack_hi(pv);
            *(f32x4*)(h + (size_t)row * 1024 + c0) = v0; *(f32x4*)(h + (size_t)row * 1024 + c0 + 4) = v1; }
        sample_ss(act, ((v0[0] * v0[0] + v0[1] * v0[1]) + (v0[2] * v0[2] + v0[3] * v0[3])) + ((v1[0] * v1[0] + v1[1] * v1[1]) + (v1[2] * v1[2] + v1[3] * v1[3])), row, pn, slot, w, fr, fq, ssw, lds);
    } };

#define XB_TMO      128
#define XB_XCNT(j)  (256  + 64 * (j))
#define XB_XSUB(j)  (1280 + 64 * (j))
#define XB_XGEN(j)  (2304 + 64 * (j))
#define XB_TOP      3328
#define XB_TOPGEN   3392
#define XCD_BAR_WORDS 3456
#define XB_SPIN_CAP (1u << 18)
__device__ __forceinline__ unsigned xb_ld(unsigned* p)              { return __hip_atomic_load(p, __ATOMIC_RELAXED, __HIP_MEMORY_SCOPE_AGENT); }
__device__ __forceinline__ unsigned xb_add(unsigned* p, unsigned v) { return __hip_atomic_fetch_add(p, v, __ATOMIC_RELAXED, __HIP_MEMORY_SCOPE_AGENT); }
__device__ __forceinline__ unsigned xb_xcc_id() { return (unsigned)__builtin_amdgcn_s_getreg((3 << 11) | 20) & 0xFu; }
#define XB_SPIN(cond, bar) do { unsigned _sp = 0; while (cond) { __builtin_amdgcn_s_sleep(1); \
    if ((++_sp & 255u) == 0u) { if (xb_ld(&(bar)[XB_TMO])) break; if (_sp > XB_SPIN_CAP) { atomicAdd(&(bar)[XB_TMO], 1u); break; } } } } while (0)
struct XcdBarrier { unsigned* bar; unsigned x; volatile LAS unsigned* st; };
__device__ __forceinline__ XcdBarrier xcd_barrier_post(unsigned* bar, volatile LAS unsigned* st) {
    XcdBarrier b; b.bar = bar; b.x = xb_xcc_id(); b.st = st;
    if (threadIdx.x == 0) (void)xb_add(&bar[XB_XCNT(b.x)], 1u);
    return b;
}
__device__ __forceinline__ void xcd_barrier_complete(unsigned* bar, unsigned x, unsigned& nloc, unsigned& nx) {
    const unsigned G = gridDim.x * gridDim.y * gridDim.z;
    unsigned sum, cnt, mine, sp = 0u;
    for (;;) {
        sum = 0u; cnt = 0u; mine = 0u;
#pragma unroll
        for (unsigned j = 0; j < 16; ++j) { const unsigned c = xb_ld(&bar[XB_XCNT(j)]); sum += c; cnt += (c > 0u) ? 1u : 0u; mine = (j == x) ? c : mine; }
        if (sum == G) break;
        __builtin_amdgcn_s_sleep(1);
        if ((++sp & 255u) == 0u) { if (xb_ld(&bar[XB_TMO])) break; if (sp > XB_SPIN_CAP) { atomicAdd(&bar[XB_TMO], 1u); break; } }
    }
    nloc = mine > 0u ? mine : 1u; nx = cnt > 0u ? cnt : 1u;
}
__device__ __forceinline__ void xcd_barrier(const XcdBarrier& b) {
    asm volatile("s_waitcnt vmcnt(0)" ::: "memory");
    __syncthreads();
    if (threadIdx.x == 0) {
        unsigned* bar = b.bar;
        __builtin_amdgcn_s_waitcnt(0);
        unsigned nloc = b.st[0], nx = b.st[1];
        if (nloc == 0u) { xcd_barrier_complete(bar, b.x, nloc, nx); b.st[0] = nloc; b.st[1] = nx; }
        const unsigned old = xb_add(&bar[XB_XSUB(b.x)], 1u);
        const unsigned gen = old / nloc;
        if (old + 1u == (gen + 1u) * nloc) {
            __builtin_amdgcn_fence(__ATOMIC_RELEASE, "agent");
            asm volatile("s_waitcnt vmcnt(0)" ::: "memory");
            const unsigned og = xb_add(&bar[XB_TOP], 1u);
            const unsigned tg = og / nx;
            if (og + 1u == (tg + 1u) * nx) xb_add(&bar[XB_TOPGEN], 1u);
            else XB_SPIN(xb_ld(&bar[XB_TOPGEN]) == tg, bar);
            __builtin_amdgcn_fence(__ATOMIC_ACQUIRE, "agent");
            xb_add(&bar[XB_XGEN(b.x)], 1u);
            asm volatile("s_waitcnt vmcnt(0)" ::: "memory");
        } else {
            XB_SPIN(xb_ld(&bar[XB_XGEN(b.x)]) == gen, bar);
            __builtin_amdgcn_fence(__ATOMIC_ACQUIRE, "agent");
            asm volatile("s_waitcnt vmcnt(0)" ::: "memory");
        }
    }
    __syncthreads();
}
__global__ void __launch_bounds__(512, 2) fwd_megakernel(Params p) {
    extern __shared__ __attribute__((aligned(16))) unsigned char lds_raw[];
    LAS unsigned char* lds = (LAS unsigned char*)lds_raw;
    cg::grid_group grid = cg::this_grid();
    unsigned char* ws = p.ws; const int G = gridDim.x, bid = blockIdx.x;
    bf16_t* hb = (bf16_t*)(ws + OFF_HB); bf16_t* big = (bf16_t*)(ws + OFF_BIG); bf16_t* sga = (bf16_t*)(ws + OFF_SGA); bf16_t* Pb = (bf16_t*)(ws + OFF_P);
    float* ssa = (float*)(ws + OFF_SSA); float* ssb = (float*)(ws + OFF_SSB); float* hres = p.out;
    const bf16_t* w1t = (const bf16_t*)(ws + OFF_WFFN); const bf16_t* w2t = (const bf16_t*)(ws + OFF_WFFN + SZ_W1T);
    const int lo = p.ph_lo, hi = p.ph_hi;
#ifndef PHMASK
#define PHMASK 0xFFF
#endif
#define IN(k) (((PHMASK >> (k)) & 1) && lo <= (k) && (k) < hi)
#define SEAM0() do { if (IN(0) && IN(1)) { asm volatile("s_waitcnt vmcnt(0) lgkmcnt(0)" ::: "memory"); grid.sync(); if (threadIdx.x < 64) { __builtin_amdgcn_fence(__ATOMIC_ACQUIRE, "agent"); asm volatile("s_waitcnt vmcnt(0)" ::: "memory"); } __syncthreads(); } } while (0)
#define SEAM(k) do { if (IN(k) && IN((k) + 1)) xcd_barrier(xbar); } while (0)
    unsigned* barw = (unsigned*)ws + 1024; volatile LAS unsigned* bst = (volatile LAS unsigned*)(lds + RS_OFF + 15360);
    if (threadIdx.x < 2) bst[threadIdx.x] = 0u;
    XcdBarrier xbar; xbar.bar = barw; xbar.x = 0; xbar.st = bst;
    if (lo == 0 && hi == NPH) xbar = xcd_barrier_post(barw, bst);
    if (lo < 0) grid.sync();
    if (IN(0)) phase_prep(p, lds);
    SEAM(0);
    if (IN(1)) { pg8::Gemm g{hb, w1t, 1024, 1024, 1024, 0}; pg8::StaticOrder S; S.init(M, 5632, G, bid); fill_rs(lds, S, ssa); EpiSwiglu E{big, (const LAS float*)(lds + RS_OFF)}; pg8::gemm_phase(lds, g, S, E);
        const int nb = (66 * 22) % G; if (bid >= nb) conv_rest(p, lds, (bid - nb) * 8 + (threadIdx.x >> 6), (G - nb) * 8); }
    SEAM(1);
    if (IN(2)) { pg8::Gemm g{big, w2t, FF, FF, FF, 0}; pg8::StaticOrder S; S.init(MP, 1024, G, bid); EpiResid E{hb, ssb, 0.5f}; pg8::gemm_phase(lds, g, S, E);
        for (int pc = bid; pc < 256; pc += G) { SEpiResid SE{hb, ssb, 0.5f}; sample_gemm(big, FF, 0, w2t, FF, FF, pc, SE, lds); }
    }
    SEAM(2);
    if (IN(3)) { pg8::Gemm g{hb, (const bf16_t*)(ws + OFF_WIN), 1024, 1024, 1024, 0}; pg8::StaticOrder S; S.init(M, NIN, G, bid);
        fill_rs(lds, S, ssb); EpiZ E{big, sga, Pb, (float*)(ws + OFF_GKLR), (const LAS float*)(lds + RS_OFF), p.in[14]}; pg8::gemm_phase(lds, g, S, E);
        conv_ffn2_idle(p, lds, G, bid, 0, (66 * 25) % G); }
    SEAM(3);
    if (IN(4)) {
        { PrepPf pf; if (bid < 1024) prep_prefetch(p, bid, pf);
          for (int it = bid; it < 1024; it += G) gla_prep_item(p, lds, it, pf, (it + G < 1024) ? it + G : -1); }
        int it0 = bid; while (it0 < 1024) it0 += G;
        for (int it = it0; it < 1024 + 256 + 128; it += G) {
            if (it < 1280) pool_prompt_item(p, it - 1024);
            else pool_sample_item(p, it - 1280);
        }
    }
    SEAM(4);
    if (IN(5)) {
        if (G >= 192) { if (bid < 128) gla_rec_item(p, lds, bid); else for (int it = bid - 128; it < 512; it += G - 128) gla_sample_item(p, lds, it); }
        else for (int it = bid; it < 640; it += G) { if (it < 128) gla_rec_item(p, lds, it); else gla_sample_item(p, lds, it - 128); }
    }
    SEAM(5);
    if (IN(6)) { pg8::Gemm g{(const bf16_t*)p.out, (const bf16_t*)(ws + OFF_WPT), 256, 1024, 256, 512}; pg8::StaticOrder S; S.init(MP, 1024, G, bid);
        fill_rso(lds, S, (const float*)(ws + OFF_OSS)); EpiMix E{sga, Pb, big, (const LAS float*)(lds + RS_OFF)}; pg8::gemm_phase(lds, g, S, E);
        for (int pc = bid; pc < 256; pc += G) { SEpiMix SE{sga, Pb, big, (const float*)(ws + OFF_OSS)}; sample_gemm((const bf16_t*)p.out, 1024, 256, (const bf16_t*)(ws + OFF_WPT), 256, 256, pc, SE, lds); }
    }
    SEAM(6);
    if (IN(7)) {
        pg8::Gemm g{sga, (const bf16_t*)(ws + OFF_WOUT), 1024, 1024, 1024, 0}; pg8::StaticOrder S; S.init(MP, 1024, G, bid);
        EpiResid E{hb, ssa, 1.0f}; pg8::gemm_phase(lds, g, S, E);
        for (int pc = bid; pc < 256; pc += G) { SEpiResid SE{hb, ssa, 1.0f}; sample_gemm(sga, 1024, 0, (const bf16_t*)(ws + OFF_WOUT), 1024, 1024, pc, SE, lds); }
    }
    SEAM(7);
    const bf16_t* w1t2 = (const bf16_t*)((const unsigned char*)p.out + Y_FFN2_OFF); const bf16_t* w2t2 = w1t2 + SZ_W1T / 2;
    if (IN(8)) { pg8::Gemm g{hb, w1t2, 1024, 1024, 1024, 0}; pg8::StaticOrder S; S.init(M, 5632, G, bid); fill_rs(lds, S, ssa); EpiSwiglu E{big, (const LAS float*)(lds + RS_OFF)}; pg8::gemm_phase(lds, g, S, E); }
    SEAM(8);
    if (IN(9)) {
        { pg8::Gemm g{big, w2t2, FF, FF, FF, 0}; pg8::StaticOrder S; S.init(MP, 1024, G, bid); EpiResid E{hb, ssb, 0.5f}; pg8::gemm_phase(lds, g, S, E); }
        { pg8::Gemm g{(const bf16_t*)(ws + OFF_PB), (const bf16_t*)(ws + OFF_WPP), 256, 256, 256, 0}; pg8::StaticOrder S; S.init(MP, 1024, G, bid); EpiBf16 E{Pb}; pg8::gemm_phase(lds, g, S, E); }
        for (int pc = bid; pc < 256; pc += G) { SEpiResid SE{hb, ssb, 0.5f}; sample_gemm(big, FF, 0, w2t2, FF, FF, pc, SE, lds); }
        for (int pc = G - 1 - bid; pc < 256; pc += G) { SEpiBf16 SE{Pb}; sample_gemm((const bf16_t*)(ws + OFF_PB), 256, 0, (const bf16_t*)(ws + OFF_WPP), 256, 256, pc, SE, lds); }
    }
    SEAM(9);
    if (IN(10)) { pg8::Gemm g{hb, (const bf16_t*)(ws + OFF_WPG), 1024, 1024, 1024, 0}; pg8::StaticOrder S; S.init(MP, 1024, G, bid); fill_rs(lds, S, ssb); EpiPle E{hres, hb, Pb, (const LAS float*)(lds + RS_OFF), ssa}; pg8::gemm_phase(lds, g, S, E);
        for (int pc = bid; pc < 256; pc += G) { SEpiPle SE{hres, hb, Pb, ssb, ssa}; sample_gemm(hb, 1024, 0, (const bf16_t*)(ws + OFF_WPG), 1024, 1024, pc, SE, lds); } }
    SEAM(10);
    if (IN(11)) {
        const int tid = threadIdx.x, lane = tid & 63, gw = bid * 8 + (tid >> 6), NGW = G * 8;
        for (int row = gw; row < M; row += NGW) { const float rs = rowscale(ssa, row, 1.0f / 1024.0f); float* hr = hres + (size_t)row * 1024;
#pragma unroll
            for (int j = 0; j < 4; ++j) { const f32x4 v = __builtin_nontemporal_load((const f32x4*)(hr + j * 256 + lane * 4)); const f32x4 fn = *(const f32x4*)(p.in[25] + j * 256 + lane * 4); __builtin_nontemporal_store(v * rs * fn, (f32x4*)(hr + j * 256 + lane * 4)); } }
    }

#ifdef DUMP
    { asm volatile("s_waitcnt vmcnt(0) lgkmcnt(0)" ::: "memory"); grid.sync(); __builtin_amdgcn_fence(__ATOMIC_ACQUIRE, "agent"); asm volatile("s_waitcnt vmcnt(0)" ::: "memory");
      const size_t n = (size_t)M * 1024;
      for (size_t i = (size_t)bid * 512 + threadIdx.x; i < n; i += (size_t)G * 512) { const size_t row = i >> 10, col = i & 1023;
#if DUMP == 1
        hres[i] = bf1(sga[i]);
#elif DUMP == 2
        hres[i] = bf1(hb[i]); (void)row; (void)col;
#elif DUMP == 3
        hres[i] = bf1(Pb[i]); if (row < MP) p.out[OUT_NGS + i] = ((const float*)(ws + OFF_OSS))[row * 64 + (col & 63)];
#endif
      } }
#endif
#undef IN
#undef SEAM
}


#ifndef MK_SPLIT
#define MK_SPLIT 0
#endif
extern "C" void kernel_launch(void* const* d_in, const int* in_sizes, int n_in, void* d_out, int out_size, void* d_ws, size_t ws_size, hipStream_t stream) {
    static int grid_blocks = 0;
    if (!grid_blocks) {
        int dev = 0, cus = 0, per_cu = 0;
        hipGetDevice(&dev); hipDeviceGetAttribute(&cus, hipDeviceAttributeMultiprocessorCount, dev);
        hipFuncSetAttribute((const void*)fwd_megakernel, hipFuncAttributeMaxDynamicSharedMemorySize, LDS_BYTES);
        hipOccupancyMaxActiveBlocksPerMultiprocessor(&per_cu, (const void*)fwd_megakernel, 512, LDS_BYTES);
        if (per_cu < 1) { fprintf(stderr, "kernel_launch: occupancy query says %d blocks per CU\n", per_cu); per_cu = 1; }
        if (per_cu > 1) per_cu = 1;
        grid_blocks = cus * per_cu;
        if (ws_size < WS_END) fprintf(stderr, "kernel_launch: workspace too small (%zu < %zu)\n", ws_size, (size_t)WS_END);
    }
#ifdef DIAG_MEMSET
    hipMemsetAsync(d_ws, 0xAA, WS_END, stream);
#endif
    (void)hipMemsetAsync((unsigned char*)d_ws + 4096, 0, XCD_BAR_WORDS * 4, stream);
    Params p{};
    for (int i = 0; i < 26; ++i) p.in[i] = (const float*)d_in[i];
    p.out = (float*)d_out; p.ws = (unsigned char*)d_ws;
#if MK_SPLIT
    for (int ph = 0; ph < NPH; ++ph) { p.ph_lo = ph; p.ph_hi = ph + 1; void* args[] = {&p};
        hipError_t e = hipLaunchCooperativeKernel((const void*)fwd_megakernel, dim3(grid_blocks), dim3(512), args, LDS_BYTES, stream);
        if (e != hipSuccess) fprintf(stderr, "launch %d failed: %s\n", ph, hipGetErrorString(e)); }
#else
    p.ph_lo = 0; p.ph_hi = NPH; void* args[] = {&p};
    hipError_t e = hipLaunchCooperativeKernel((const void*)fwd_megakernel, dim3(grid_blocks), dim3(512), args, LDS_BYTES, stream);
    if (e != hipSuccess) fprintf(stderr, "cooperative launch failed: %s (grid %d)\n", hipGetErrorString(e), grid_blocks);
#endif
}
```
